# Optimizing an MI355X kernel written in HIP

```python
import jax, jax.numpy as jnp
from jax import lax
import numpy as np

D_MODEL = 1024
BATCH = 4
SEQ = 8192
DEPTH = 2
DEC_BATCH = 1
DEC_SEQ = 16384
PAST_LEN = 128

HEAD_DIM = 64
D_MIX = D_MODEL
A_HEADS = 6
A_KV_HEADS = 2
A_GROUP = A_HEADS // A_KV_HEADS
B_GROUPS = 4
C_HEADS = 6
A_Q = A_HEADS * HEAD_DIM
A_KV = A_KV_HEADS * HEAD_DIM
B_W = B_GROUPS * HEAD_DIM
C_W = C_HEADS * HEAD_DIM
IN_SPLIT = (A_Q, A_KV, A_KV, B_W, B_W, C_W, C_W, C_W)
D_IN = sum(IN_SPLIT)
BLOCK = 128
WINDOW = 128
CHUNK = 128
GRID_W = 64
NA_KH = 8
NA_KW = 16
ROPE_THETA = 500000.0
ROPE_DIMS = HEAD_DIM // 4
D_FF = 4 * D_MODEL
EPS = 1e-6
ATTN_SCALE = HEAD_DIM ** -0.5

kernel_name = 'hybrid_parallel_heads_encoder'


def _rmsnorm(x, g):
    xf = x.astype(jnp.float32)
    y = xf * lax.rsqrt(jnp.mean(xf * xf, axis=-1, keepdims=True) + EPS)
    return (y * g.astype(jnp.float32)).astype(x.dtype)


def _rope(x):
    S = x.shape[1]
    half = ROPE_DIMS // 2
    inv = ROPE_THETA ** (-jnp.arange(0, ROPE_DIMS, 2, dtype=jnp.float32) / ROPE_DIMS)
    ang = jnp.arange(S, dtype=jnp.float32)[:, None] * inv[None, :]
    cos = jnp.cos(ang)[None, :, None, :]
    sin = jnp.sin(ang)[None, :, None, :]
    xr = x[..., :ROPE_DIMS].astype(jnp.float32)
    x1, x2 = xr[..., :half], xr[..., half:]
    rot = jnp.concatenate([x1 * cos - x2 * sin, x2 * cos + x1 * sin], axis=-1)
    return jnp.concatenate([rot.astype(x.dtype), x[..., ROPE_DIMS:]], axis=-1)


def _window_gqa(q, k, v, sink):
    Bn, S = q.shape[0], q.shape[1]
    nb = S // BLOCK
    pad = ((0, 0), (BLOCK, BLOCK), (0, 0), (0, 0))
    kp = jnp.pad(k, pad).reshape(Bn, nb + 2, BLOCK, A_KV_HEADS, HEAD_DIM)
    vp = jnp.pad(v, pad).reshape(Bn, nb + 2, BLOCK, A_KV_HEADS, HEAD_DIM)
    kb = jnp.concatenate([kp[:, :-2], kp[:, 1:-1], kp[:, 2:]], axis=2)
    vb = jnp.concatenate([vp[:, :-2], vp[:, 1:-1], vp[:, 2:]], axis=2)
    qb = q.reshape(Bn, nb, BLOCK, A_KV_HEADS, A_GROUP, HEAD_DIM)
    s = jnp.einsum('bnqhgd,bnkhd->bnhgqk', qb, kb,
                   preferred_element_type=jnp.float32) * ATTN_SCALE
    qi = jnp.arange(BLOCK)[:, None]
    kj = jnp.arange(3 * BLOCK)[None, :]
    in_win = jnp.abs(kj - BLOCK - qi) <= WINDOW
    kabs = jnp.arange(nb)[:, None, None] * BLOCK + kj[None] - BLOCK
    mask = in_win[None] & (kabs >= 0) & (kabs < S)
    s = jnp.where(mask[None, :, None, None], s, -jnp.inf)
    sink_col = jnp.broadcast_to(
        sink.astype(jnp.float32).reshape(1, 1, A_KV_HEADS, A_GROUP, 1, 1), s.shape[:-1] + (1,))
    p = jax.nn.softmax(jnp.concatenate([s, sink_col], axis=-1), axis=-1)[..., :-1]
    o = jnp.einsum('bnhgqk,bnkhd->bnqhgd', p.astype(v.dtype), vb)
    return o.reshape(Bn, S, A_Q)


def _spatial_gate(u, v, g_v, w_s, b_s):
    Bn, S = u.shape[0], u.shape[1]
    nc = S // CHUNK
    vr = _rmsnorm(v, g_v).reshape(Bn, nc, CHUNK, B_GROUPS, HEAD_DIM)
    sv = jnp.einsum('gpq,bcqge->bcpge', w_s.astype(vr.dtype), vr) + b_s.T[None, None, :, :, None].astype(vr.dtype)
    return u * sv.reshape(Bn, S, B_W)


def _neighbourhood_attn(q, k, v, rel_bias):
    Bn, S = q.shape[0], q.shape[1]
    rows = S // GRID_W
    kh = min(NA_KH, rows)
    r = jnp.arange(rows)
    rs = jnp.clip(r - kh // 2, 0, rows - kh)
    row_idx = rs[:, None] + jnp.arange(kh)[None, :]
    col = jnp.arange(GRID_W)
    cs = jnp.clip(col - NA_KW // 2, 0, GRID_W - NA_KW)
    qg = q.reshape(Bn, rows, GRID_W, C_HEADS, HEAD_DIM)
    kg = k.reshape(Bn, rows, GRID_W, C_HEADS, HEAD_DIM)[:, row_idx]
    vg = v.reshape(Bn, rows, GRID_W, C_HEADS, HEAD_DIM)[:, row_idx]
    s = jnp.einsum('brqhd,brkwhd->brhqkw', qg, kg,
                   preferred_element_type=jnp.float32) * ATTN_SCALE
    dr = row_idx - r[:, None] + NA_KH - 1
    dc = jnp.clip(col[None, :] - col[:, None] + NA_KW - 1, 0, 2 * NA_KW - 2)
    bias = rel_bias[:, dr[:, :, None, None], dc[None, None]]
    bias = bias.transpose(1, 0, 3, 2, 4).astype(jnp.float32)
    col_in = (col[None, :] >= cs[:, None]) & (col[None, :] < cs[:, None] + NA_KW)
    s = jnp.where(col_in[:, None, :], s + bias[None], -jnp.inf)
    sh = s.shape
    p = jax.nn.softmax(s.reshape(sh[:4] + (kh * GRID_W,)), axis=-1).reshape(sh)
    o = jnp.einsum('brhqkw,brkwhd->brqhd', p.astype(v.dtype), vg)
    return o.reshape(Bn, S, C_W)


def _layer(x, c, norm1_g, norm2_g, w_ada, b_ada, w_in, qa_norm_g, ka_norm_g, a_sink,
           bv_norm_g, w_spatial, b_spatial, qc_norm_g, kc_norm_g, c_rel_bias,
           w_out, w_ff1, w_ff2):
    Bn, S = x.shape[0], x.shape[1]
    mod = (jax.nn.silu(c) @ w_ada + b_ada)[:, None, :]
    shift1, scale1, gate1, shift2, scale2, gate2 = jnp.split(mod, 6, axis=-1)
    h = _rmsnorm(x, norm1_g) * (1 + scale1) + shift1
    proj = h @ w_in
    aq, ak, av, bu, bv, cq, ck, cv = jnp.split(proj, list(np.cumsum(IN_SPLIT)[:-1]), axis=-1)
    aq = _rope(_rmsnorm(aq.reshape(Bn, S, A_HEADS, HEAD_DIM), qa_norm_g))
    ak = _rope(_rmsnorm(ak.reshape(Bn, S, A_KV_HEADS, HEAD_DIM), ka_norm_g))
    av = av.reshape(Bn, S, A_KV_HEADS, HEAD_DIM)
    out_a = _window_gqa(aq, ak, av, a_sink)
    out_b = _spatial_gate(jax.nn.gelu(bu), jax.nn.gelu(bv), bv_norm_g, w_spatial, b_spatial)
    cq = _rmsnorm(cq.reshape(Bn, S, C_HEADS, HEAD_DIM), qc_norm_g)
    ck = _rmsnorm(ck.reshape(Bn, S, C_HEADS, HEAD_DIM), kc_norm_g)
    cv = cv.reshape(Bn, S, C_HEADS, HEAD_DIM)
    out_c = _neighbourhood_attn(cq, ck, cv, c_rel_bias)
    mix = jnp.concatenate([out_a, out_b, out_c], axis=-1) @ w_out
    x = x + gate1 * mix
    h2 = _rmsnorm(x, norm2_g) * (1 + scale2) + shift2
    ff = jnp.square(jax.nn.relu(h2 @ w_ff1)) @ w_ff2
    return x + gate2 * ff


def _trunk(x, c, norm1_g, norm2_g, w_ada, b_ada, w_in, qa_norm_g, ka_norm_g, a_sink,
           bv_norm_g, w_spatial, b_spatial, qc_norm_g, kc_norm_g, c_rel_bias,
           w_out, w_ff1, w_ff2):
    for l in range(DEPTH):
        x = _layer(x, c, norm1_g[l], norm2_g[l], w_ada[l], b_ada[l], w_in[l],
                   qa_norm_g[l], ka_norm_g[l], a_sink[l], bv_norm_g[l], w_spatial[l],
                   b_spatial[l], qc_norm_g[l], kc_norm_g[l], c_rel_bias[l],
                   w_out[l], w_ff1[l], w_ff2[l])
    return x


def setup_inputs(seed: int = 0) -> dict:
    key = jax.random.key(seed)
    ks = jax.random.split(key, 24)
    f32 = jnp.float32

    def nrm(k, shape, s):
        return s * jax.random.normal(k, shape, f32)

    return {
        'x_prompt': nrm(ks[0], (BATCH, SEQ, D_MODEL), 1.0),
        'x_sample': nrm(ks[1], (DEC_BATCH, DEC_SEQ, D_MODEL), 1.0),
        'c_prompt': nrm(ks[2], (BATCH, D_MODEL), 1.0),
        'c_sample': nrm(ks[3], (DEC_BATCH, D_MODEL), 1.0),
        'norm1_g': 1.0 + nrm(ks[4], (DEPTH, D_MODEL), 0.02),
        'norm2_g': 1.0 + nrm(ks[5], (DEPTH, D_MODEL), 0.02),
        'w_ada': nrm(ks[6], (DEPTH, D_MODEL, 6 * D_MODEL), 0.5 * D_MODEL ** -0.5),
        'b_ada': nrm(ks[7], (DEPTH, 6 * D_MODEL), 0.02),
        'w_in': nrm(ks[8], (DEPTH, D_MODEL, D_IN), D_MODEL ** -0.5),
        'qa_norm_g': 1.0 + nrm(ks[9], (DEPTH, HEAD_DIM), 0.02),
        'ka_norm_g': 1.0 + nrm(ks[10], (DEPTH, HEAD_DIM), 0.02),
        'a_sink': nrm(ks[11], (DEPTH, A_HEADS), 1.0),
        'bv_norm_g': 1.0 + nrm(ks[12], (DEPTH, B_W), 0.02),
        'w_spatial': nrm(ks[13], (DEPTH, B_GROUPS, CHUNK, CHUNK), 0.5 * CHUNK ** -0.5),
        'b_spatial': 1.0 + nrm(ks[14], (DEPTH, B_GROUPS, CHUNK), 0.02),
        'qc_norm_g': 1.0 + nrm(ks[15], (DEPTH, HEAD_DIM), 0.02),
        'kc_norm_g': 1.0 + nrm(ks[16], (DEPTH, HEAD_DIM), 0.02),
        'c_rel_bias': nrm(ks[17], (DEPTH, C_HEADS, 2 * NA_KH - 1, 2 * NA_KW - 1), 0.5),
        'w_out': nrm(ks[18], (DEPTH, D_MIX, D_MODEL), D_MIX ** -0.5),
        'w_ff1': nrm(ks[19], (DEPTH, D_MODEL, D_FF), D_MODEL ** -0.5),
        'w_ff2': nrm(ks[20], (DEPTH, D_FF, D_MODEL), D_FF ** -0.5),
    }


def reference(x_prompt, x_sample, c_prompt, c_sample, norm1_g, norm2_g, w_ada, b_ada,
              w_in, qa_norm_g, ka_norm_g, a_sink, bv_norm_g, w_spatial, b_spatial,
              qc_norm_g, kc_norm_g, c_rel_bias, w_out, w_ff1, w_ff2):
    y_prompt = _trunk(x_prompt, c_prompt, norm1_g, norm2_g, w_ada, b_ada, w_in,
                      qa_norm_g, ka_norm_g, a_sink, bv_norm_g, w_spatial, b_spatial,
                      qc_norm_g, kc_norm_g, c_rel_bias, w_out, w_ff1, w_ff2)
    y_sample = _trunk(x_sample, c_sample, norm1_g, norm2_g, w_ada, b_ada, w_in,
                      qa_norm_g, ka_norm_g, a_sink, bv_norm_g, w_spatial, b_spatial,
                      qc_norm_g, kc_norm_g, c_rel_bias, w_out, w_ff1, w_ff2)
    return (y_prompt, y_sample)
```

```cpp
#include <hip/hip_runtime.h>
#include <hip/hip_cooperative_groups.h>
#include <cstdio>
#include <cstdint>
namespace cg = cooperative_groups;
__device__ __forceinline__ int lane_id_asm() { int l; asm volatile("v_mbcnt_lo_u32_b32 %0, -1, 0\n\tv_mbcnt_hi_u32_b32 %0, -1, %0" : "=v"(l)); return l; }
namespace pg8 {
#define PG8_LAS __attribute__((address_space(3)))
typedef unsigned short bf16_t;
typedef short bf16x8 __attribute__((ext_vector_type(8)));
typedef float f32x4 __attribute__((ext_vector_type(4)));
typedef unsigned u32x4 __attribute__((ext_vector_type(4)));
constexpr int BM = 256, BK = 64, HALF = 128, HTB = HALF * BK * 2  , STAGE_BYTES = 8 * HTB, NXCD = 8, WGM = 8;

__host__ __device__ __forceinline__ int lds_byte(int r, int c) { const int st = (r >> 4) * 2 + (c >> 5), rr = r & 15, cc = c & 31, ob = rr * 64 + cc * 2; return st * 1024 + (ob ^ (((ob >> 9) & 1) << 5)); }
__host__ __device__ __forceinline__ void stage_rc(int b, int& R, int& C) { const int st = b / 1024, sb = b % 1024, swz = sb ^ (((sb >> 9) & 1) << 5); R = (st >> 1) * 16 + swz / 64; C = (st & 1) * 32 + (swz % 64) / 2; }
__host__ __device__ __forceinline__ int perm32(int rho) { const int n = rho >> 4, i = rho & 15; return 8 * (i >> 2) + 4 * n + (i & 3); }

struct Unit { int pm, pn; };
struct Gemm { const bf16_t* A; const bf16_t* Bt; int M, N, K; };

struct StaticOrder {
    int nM, nN, nwg, G, c;
    __host__ __device__ void init(int M, int N, int G_, int c_) { nM = M / BM; nN = N / BM; nwg = nM * nN; G = G_; c = c_; }
    __host__ __device__ bool next(int i, Unit& u) const {
        const long L = (long)i * G + c; if (L >= nwg) return false;
        int wgid = (int)L; { const int q = nwg / NXCD, r = nwg % NXCD, xcd = wgid % NXCD, off = wgid / NXCD; wgid = (xcd < r ? xcd * (q + 1) : r * (q + 1) + (xcd - r) * q) + off; }
        const int nig = WGM * nN, gid = wgid / nig, fm = gid * WGM, gsz = (nM - fm) < WGM ? (nM - fm) : WGM;
        u.pm = fm + ((wgid % nig) % gsz); u.pn = (wgid % nig) / gsz; return true;
    }
    __device__ __forceinline__ void a_ready(const Unit&) const {}
    __device__ __forceinline__ void done(const Unit&) const {}
};

__device__ __forceinline__ unsigned cvt_pk_bf16(float lo, float hi) { unsigned r; asm volatile("v_cvt_pk_bf16_f32 %0, %1, %2" : "=v"(r) : "v"(lo), "v"(hi)); return r; }
template <int ACT  > struct EpiBf16 {
    static constexpr bool PERM = true, AFTER_DRAIN = false;
    bf16_t* O; int ldc;
    __device__ __forceinline__ void operator()(const f32x4 (&acc)[2][2][4][2], const Unit& u, int wr, int wc, int fr, int fq) const {
        const int row0 = u.pm * BM + wr * 64 + fr; const int col0 = u.pn * BM + wc * 32 + 8 * fq;
#pragma unroll
        for (int ai = 0; ai < 2; ++ai)
#pragma unroll
            for (int m = 0; m < 4; ++m) { bf16_t* rowp = O + (size_t)(row0 + ai * HALF + m * 16) * ldc + col0;
#pragma unroll
                for (int bj = 0; bj < 2; ++bj) { f32x4 v0 = acc[ai][bj][m][0], v1 = acc[ai][bj][m][1];
                    if (ACT == 2) {
#pragma unroll
                        for (int e = 0; e < 4; ++e) { const float a = fmaxf(v0[e], 0.f), b = fmaxf(v1[e], 0.f); v0[e] = a * a; v1[e] = b * b; } }
                    u32x4 w; w.x = cvt_pk_bf16(v0[0], v0[1]); w.y = cvt_pk_bf16(v0[2], v0[3]); w.z = cvt_pk_bf16(v1[0], v1[1]); w.w = cvt_pk_bf16(v1[2], v1[3]);
                    *(u32x4*)(rowp + bj * HALF) = w; } }
    }
};
struct EpiResGate {
    static constexpr bool PERM = false, AFTER_DRAIN = false;
    const float* baseA; const float* baseB; int split; float* out; const float* gate; int gate_stride; int row_off;
    __device__ __forceinline__ void operator()(const f32x4 (&acc)[2][2][4][2], const Unit& u, int wr, int wc, int fr, int fq) const {
        const int R0 = row_off + u.pm * BM; int b = R0 >> 13; b = b > 4 ? 4 : b;
        const float* g = gate + (size_t)b * gate_stride;
        const float* base = (R0 < split) ? baseA + (size_t)R0 * 1024 : baseB + (size_t)(R0 - split) * 1024;
        float* o = out + (size_t)R0 * 1024;
        const int col0 = u.pn * BM + wc * 32 + 4 * fq;
        f32x4 gv[2][2];
#pragma unroll
        for (int bj = 0; bj < 2; ++bj)
#pragma unroll
            for (int n = 0; n < 2; ++n) gv[bj][n] = *(const f32x4*)(g + col0 + bj * HALF + n * 16);
#pragma unroll
        for (int ai = 0; ai < 2; ++ai)
#pragma unroll
            for (int m = 0; m < 4; ++m) { const size_t off = (size_t)(ai * HALF + wr * 64 + m * 16 + fr) * 1024 + col0;
#pragma unroll
                for (int bj = 0; bj < 2; ++bj)
#pragma unroll
                    for (int n = 0; n < 2; ++n) { const f32x4 bs = *(const f32x4*)(base + off + bj * HALF + n * 16);
                        *(f32x4*)(o + off + bj * HALF + n * 16) = bs + gv[bj][n] * acc[ai][bj][m][n]; } }
    }
};

__device__ __forceinline__ float gelu_t(float x) { const float u = 0.7978845608028654f * (x + 0.044715f * x * x * x); return x * __builtin_amdgcn_rcpf(1.f + __builtin_amdgcn_exp2f(-2.8853900817779268f * u)); }
template <int ACT  > struct EpiBf16N {
    static constexpr bool PERM = true, AFTER_DRAIN = false;
    bf16_t* O; int ldc; const float* rowss; const float* bias; int ldb; int row_off; int gelu_lo, gelu_hi;
    __device__ __forceinline__ void operator()(const f32x4 (&acc)[2][2][4][2], const Unit& u, int wr, int wc, int fr, int fq) const {
        int zz = 0; asm volatile("" : "+v"(zz));
        const int R0 = row_off + u.pm * BM; int b = R0 >> 13; b = b > 4 ? 4 : b;
        const int lrow0 = u.pm * BM + wr * 64 + fr + zz; const int col0 = u.pn * BM + wc * 32 + 8 * fq + zz;
        const float* rss0_ = rowss; bf16_t* O0_ = O; const float* bias0_ = bias; asm volatile("" : "+s"(rss0_), "+s"(O0_), "+s"(bias0_));
        typedef __attribute__((address_space(1))) const float gcf; typedef __attribute__((address_space(1))) bf16_t gbf;
        gcf* rss_ = (gcf*)rss0_; gbf* O_ = (gbf*)O0_; gcf* bias_ = (gcf*)bias0_;
        gcf* bp = bias_ + (size_t)b * ldb + col0;
        f32x4 bv[2][2];
#pragma unroll
        for (int bj = 0; bj < 2; ++bj)
#pragma unroll
            for (int n = 0; n < 2; ++n) bv[bj][n] = *(const __attribute__((address_space(1))) f32x4*)(bp + bj * HALF + 4 * n);
        float rinvs[2][4];
#pragma unroll
        for (int ai = 0; ai < 2; ++ai)
#pragma unroll
            for (int m = 0; m < 4; ++m) rinvs[ai][m] = rss_[row_off + lrow0 + ai * HALF + m * 16];
#pragma unroll
        for (int ai = 0; ai < 2; ++ai)
#pragma unroll
            for (int m = 0; m < 4; ++m) { const int lr = lrow0 + ai * HALF + m * 16; gbf* rowp = O_ + (size_t)lr * ldc + col0;
                const float rinv = rsqrtf(rinvs[ai][m] * (1.f / 1024.f) + 1e-6f);
#pragma unroll
                for (int bj = 0; bj < 2; ++bj) { f32x4 v0 = acc[ai][bj][m][0] * rinv + bv[bj][0], v1 = acc[ai][bj][m][1] * rinv + bv[bj][1];
                    if (ACT == 2) {
#pragma unroll
                        for (int e = 0; e < 4; ++e) { const float a = fmaxf(v0[e], 0.f), b2 = fmaxf(v1[e], 0.f); v0[e] = a * a; v1[e] = b2 * b2; } }
                    if (ACT == 0) { const int cb = u.pn * BM + bj * HALF; if (cb >= gelu_lo && cb < gelu_hi) {
#pragma unroll
                        for (int e = 0; e < 4; ++e) { v0[e] = gelu_t(v0[e]); v1[e] = gelu_t(v1[e]); } } }
                    u32x4 w; w.x = cvt_pk_bf16(v0[0], v0[1]); w.y = cvt_pk_bf16(v0[2], v0[3]); w.z = cvt_pk_bf16(v1[0], v1[1]); w.w = cvt_pk_bf16(v1[2], v1[3]);
                    *(__attribute__((address_space(1))) u32x4*)(rowp + bj * HALF) = w; } }
    }
};
struct EpiResGateN {
    static constexpr bool PERM = true, AFTER_DRAIN = false;
    const float* baseA; const float* baseB; int split; float* out; const float* gate; int gate_stride; int row_off;
    bf16_t* XA; const float* ag; const float* ascale; float* rss; int do_next;
    __device__ __forceinline__ void operator()(const f32x4 (&acc)[2][2][4][2], const Unit& u, int wr, int wc, int fr, int fq) const {
        typedef unsigned u32x2 __attribute__((ext_vector_type(2)));
        const int R0 = row_off + u.pm * BM; int b = R0 >> 13; b = b > 4 ? 4 : b;
        const float* g = gate + (size_t)b * gate_stride;
        const float* base = (R0 < split) ? baseA + (size_t)R0 * 1024 : baseB + (size_t)(R0 - split) * 1024;
        float* o = out + (size_t)R0 * 1024; bf16_t* xa_ = XA + (size_t)R0 * 1024; float* rss_ = rss + R0;
        asm volatile("" : "+s"(g), "+s"(base), "+s"(o), "+s"(xa_), "+s"(rss_));
        typedef __attribute__((address_space(1))) const f32x4 gcv4; typedef __attribute__((address_space(1))) f32x4 gv4; typedef __attribute__((address_space(1))) u32x2 gu2;
        const __attribute__((address_space(1))) float* gg_ = (const __attribute__((address_space(1))) float*)g; const __attribute__((address_space(1))) float* gbase = (const __attribute__((address_space(1))) float*)base;
        __attribute__((address_space(1))) float* go = (__attribute__((address_space(1))) float*)o; __attribute__((address_space(1))) bf16_t* gxa = (__attribute__((address_space(1))) bf16_t*)xa_; __attribute__((address_space(1))) float* grss = (__attribute__((address_space(1))) float*)rss_;
        const __attribute__((address_space(1))) float* gag = (const __attribute__((address_space(1))) float*)ag; const __attribute__((address_space(1))) float* gasc = (const __attribute__((address_space(1))) float*)ascale;
        int zz = 0; asm volatile("" : "+v"(zz));
        const int col0 = u.pn * BM + wc * 32 + 8 * fq + zz;
        f32x4 gv[2][2], av[2][2];
#pragma unroll
        for (int bj = 0; bj < 2; ++bj)
#pragma unroll
            for (int n = 0; n < 2; ++n) { gv[bj][n] = *(gcv4*)(gg_ + col0 + bj * HALF + n * 4);
                if (do_next) av[bj][n] = *(gcv4*)(gag + col0 + bj * HALF + n * 4) * (*(gcv4*)(gasc + (size_t)b * gate_stride + col0 + bj * HALF + n * 4) + 1.f);
                else av[bj][n] = (f32x4){0.f, 0.f, 0.f, 0.f}; }
        f32x4 bs[2][2][2];
        const unsigned rc0 = (unsigned)(wr * 64 + fr + zz) * 1024u + (unsigned)col0;
#define RG_LOAD(rg, buf) do { const unsigned off_ = rc0 + (unsigned)(((rg) >> 2) * HALF + ((rg) & 3) * 16) * 1024u; \
        _Pragma("unroll") for (int bj = 0; bj < 2; ++bj) _Pragma("unroll") for (int n = 0; n < 2; ++n) bs[buf][bj][n] = *(gcv4*)(gbase + off_ + bj * HALF + n * 4); } while (0)
        RG_LOAD(0, 0);
#pragma unroll
        for (int rg = 0; rg < 8; ++rg) {
            const int ai = rg >> 2, m = rg & 3;
            if (rg + 1 < 8) RG_LOAD(rg + 1, (rg + 1) & 1);
            __builtin_amdgcn_sched_barrier(0);
            const int r = ai * HALF + wr * 64 + m * 16 + fr; const unsigned off = rc0 + (unsigned)(ai * HALF + m * 16) * 1024u; float ssq = 0.f;
#pragma unroll
            for (int bj = 0; bj < 2; ++bj) { f32x4 x[2];
#pragma unroll
                for (int n = 0; n < 2; ++n) { x[n] = bs[rg & 1][bj][n] + gv[bj][n] * acc[ai][bj][m][n]; *(gv4*)(go + off + bj * HALF + n * 4) = x[n]; }
                if (do_next) { ssq += ((x[0][0] * x[0][0] + x[0][1] * x[0][1]) + (x[0][2] * x[0][2] + x[0][3] * x[0][3])) + ((x[1][0] * x[1][0] + x[1][1] * x[1][1]) + (x[1][2] * x[1][2] + x[1][3] * x[1][3]));
                    const f32x4 y0 = x[0] * av[bj][0], y1 = x[1] * av[bj][1];
                    u32x4 w; w.x = cvt_pk_bf16(y0[0], y0[1]); w.y = cvt_pk_bf16(y0[2], y0[3]); w.z = cvt_pk_bf16(y1[0], y1[1]); w.w = cvt_pk_bf16(y1[2], y1[3]);
                    *(__attribute__((address_space(1))) u32x4*)(gxa + off + bj * HALF) = w; } }
            if (do_next) { ssq += __shfl_xor(ssq, 16); ssq += __shfl_xor(ssq, 32);
                if (fq == 0) __hip_atomic_fetch_add((float*)(grss + r), ssq, __ATOMIC_RELAXED, __HIP_MEMORY_SCOPE_AGENT); }
            __builtin_amdgcn_sched_barrier(0);
        }
#undef RG_LOAD
    }
};
template <class Epi, class Sched, bool ALIGN_EPI = false, bool SP2 = false>
__device__ __forceinline__ void gemm_phase(PG8_LAS unsigned char* lds, const Gemm g, const Sched& S, const Epi& E, int wave_in) {
    int tid_ = wave_in * 64 + ::lane_id_asm();
    const int tid = tid_, wid = __builtin_amdgcn_readfirstlane(tid >> 6), lane = tid & 63, wr = wid >> 2, wc = wid & 3, fr = lane & 15, fq = lane >> 4;
    const int K = g.K, nt = K / BK;
    unsigned voffA[2], voffB[2];
#pragma unroll
    for (int i = 0; i < 2; ++i) { int R, C; stage_rc(tid * 16 + i * 8192, R, C); const int Rb = Epi::PERM ? ((R & ~31) + perm32(R & 31)) : R;
        voffA[i] = (unsigned)(R * K + C) * 2u; voffB[i] = (unsigned)(Rb * K + C) * 2u; }
    const size_t kstep = (size_t)(BK * 2);
    const size_t hstep = (size_t)HALF * K * 2;
    const size_t tstep = 2 * hstep;
    const unsigned ldsw = (unsigned)wid * 1024u;
    const int aoff = lds_byte(wr * 64 + fr, fq * 8), boff = lds_byte(wc * 32 + fr, fq * 8);
#define PG8_SA(b, h) (((b) * 2 + (h)) * HTB)
#define PG8_SB(b, h) ((4 + (b) * 2 + (h)) * HTB)
#define PG8_STAGE(bufoff, gbase, voff) do { _Pragma("unroll") for (int _i = 0; _i < 2; ++_i) \
        __builtin_amdgcn_global_load_lds((const unsigned*)((const char*)(gbase) + (voff)[_i]), (PG8_LAS unsigned*)(lds + (bufoff) + ldsw + _i * 8192), 16, 0, 0); } while (0)
#define PG8_LDA(dst, b, h) do { _Pragma("unroll") for (int m = 0; m < 4; ++m) _Pragma("unroll") for (int k = 0; k < 2; ++k) dst[m][k] = *(const PG8_LAS bf16x8*)(lds + PG8_SA(b, h) + aoff + m * 2048 + k * 1024); } while (0)
#define PG8_LDB(dst, b, h) do { _Pragma("unroll") for (int n = 0; n < 2; ++n) _Pragma("unroll") for (int k = 0; k < 2; ++k) dst[n][k] = *(const PG8_LAS bf16x8*)(lds + PG8_SB(b, h) + boff + n * 2048 + k * 1024); } while (0)
#define PG8_MMA(ai, bj, At, Bt) do { __builtin_amdgcn_s_setprio(1); _Pragma("unroll") for (int m = 0; m < 4; ++m) _Pragma("unroll") for (int n = 0; n < 2; ++n) _Pragma("unroll") for (int k = 0; k < 2; ++k) \
        acc[ai][bj][m][n] = __builtin_amdgcn_mfma_f32_16x16x32_bf16(Bt[n][k], At[m][k], acc[ai][bj][m][n], 0, 0, 0); __builtin_amdgcn_s_setprio(0); } while (0)
#define PG8_WAIT_V(n) asm volatile("s_waitcnt vmcnt(" #n ")" ::: "memory")
#define PG8_WAIT_L(n) asm volatile("s_waitcnt lgkmcnt(" #n ")" ::: "memory")
#define PG8_BAR __builtin_amdgcn_s_barrier()
#define PG8_SCHED __builtin_amdgcn_sched_barrier(0)
    Unit cur, nxt; int ui = 0;
    if (!S.next(0, cur)) return;
    f32x4 acc[2][2][4][2];
#pragma unroll
    for (int a = 0; a < 2; ++a)
#pragma unroll
        for (int b = 0; b < 2; ++b)
#pragma unroll
            for (int m = 0; m < 4; ++m)
#pragma unroll
                for (int n = 0; n < 2; ++n) acc[a][b][m][n] = (f32x4){0.f, 0.f, 0.f, 0.f};
    bf16x8 At[4][2], B0[2][2], B1[2][2];
    const char* cA = (const char*)g.A + (size_t)cur.pm * tstep; const char* cB = (const char*)g.Bt + (size_t)cur.pn * tstep;
    S.a_ready(cur);
    if constexpr (SP2) {
        PG8_STAGE(PG8_SB(0, 0), cB, voffB); PG8_STAGE(PG8_SB(0, 1), cB + hstep, voffB); PG8_STAGE(PG8_SA(0, 0), cA, voffA); PG8_STAGE(PG8_SA(0, 1), cA + hstep, voffA);
        if (wr == 1) PG8_BAR;
        PG8_WAIT_V(2); PG8_BAR;
        PG8_STAGE(PG8_SB(1, 0), cB + kstep, voffB); PG8_STAGE(PG8_SA(1, 0), cA + kstep, voffA); PG8_STAGE(PG8_SB(1, 1), cB + hstep + kstep, voffB);
        PG8_WAIT_V(6); PG8_BAR;
    } else {
        PG8_STAGE(PG8_SB(0, 0), cB, voffB); PG8_STAGE(PG8_SA(0, 0), cA, voffA); PG8_STAGE(PG8_SB(0, 1), cB + hstep, voffB); PG8_STAGE(PG8_SA(0, 1), cA + hstep, voffA);
        if (wr == 1) PG8_BAR;
        PG8_WAIT_V(4); PG8_BAR;
        PG8_STAGE(PG8_SB(1, 0), cB + kstep, voffB); PG8_STAGE(PG8_SA(1, 0), cA + kstep, voffA); PG8_STAGE(PG8_SB(1, 1), cB + hstep + kstep, voffB);
        PG8_WAIT_V(6); PG8_BAR;
    }
    for (;;) {
        const bool has_next = S.next(ui + 1, nxt);
        const char* nA = has_next ? (const char*)g.A + (size_t)nxt.pm * tstep : cA; const char* nB = has_next ? (const char*)g.Bt + (size_t)nxt.pn * tstep : cB;
        for (int t = 0; t < nt; t += 2) {
            const bool last = (t == nt - 2);
            const char* a1 = cA + (size_t)(t + 1) * kstep;
            const char* a2 = last ? nA : cA + (size_t)(t + 2) * kstep; const char* b2 = last ? nB : cB + (size_t)(t + 2) * kstep;
            const char* a3 = a2 + kstep; const char* b3 = b2 + kstep;
            if (last && has_next) S.a_ready(nxt);
            if constexpr (SP2) {
            PG8_LDB(B0, 0, 0); PG8_LDB(B1, 0, 1); PG8_SCHED; PG8_LDA(At, 0, 0); PG8_STAGE(PG8_SA(1, 1), a1 + hstep, voffA);
            PG8_WAIT_V(8); PG8_WAIT_L(0); PG8_BAR; PG8_MMA(0, 0, At, B0); PG8_MMA(0, 1, At, B1); PG8_BAR; PG8_SCHED;
            PG8_LDA(At, 0, 1); PG8_STAGE(PG8_SB(0, 0), b2, voffB); PG8_STAGE(PG8_SB(0, 1), b2 + hstep, voffB); PG8_STAGE(PG8_SA(0, 0), a2, voffA);
            PG8_WAIT_V(8); PG8_WAIT_L(0); PG8_BAR; PG8_MMA(1, 0, At, B0); PG8_MMA(1, 1, At, B1); PG8_BAR; PG8_SCHED;
            PG8_LDB(B0, 1, 0); PG8_LDB(B1, 1, 1); PG8_SCHED; PG8_LDA(At, 1, 0); PG8_STAGE(PG8_SA(0, 1), a2 + hstep, voffA);
            PG8_WAIT_V(8); PG8_WAIT_L(0); PG8_BAR; PG8_MMA(0, 0, At, B0); PG8_MMA(0, 1, At, B1); PG8_BAR; PG8_SCHED;
            PG8_LDA(At, 1, 1); PG8_STAGE(PG8_SB(1, 0), b3, voffB); PG8_STAGE(PG8_SB(1, 1), b3 + hstep, voffB); PG8_STAGE(PG8_SA(1, 0), a3, voffA);
            PG8_WAIT_V(8); PG8_WAIT_L(0); PG8_BAR; PG8_MMA(1, 0, At, B0); PG8_MMA(1, 1, At, B1); PG8_BAR; PG8_SCHED;
            } else {
            PG8_LDB(B0, 0, 0); PG8_SCHED; PG8_LDA(At, 0, 0); PG8_STAGE(PG8_SA(1, 1), a1 + hstep, voffA);
            PG8_WAIT_L(8); PG8_BAR; PG8_WAIT_L(0); PG8_MMA(0, 0, At, B0); PG8_BAR; PG8_SCHED;
            PG8_LDB(B1, 0, 1); PG8_STAGE(PG8_SB(0, 0), b2, voffB);
            PG8_BAR; PG8_WAIT_L(0); PG8_MMA(0, 1, At, B1); PG8_BAR;
            PG8_LDA(At, 0, 1); PG8_STAGE(PG8_SA(0, 0), a2, voffA);
            PG8_BAR; PG8_WAIT_L(0); PG8_MMA(1, 0, At, B0); PG8_BAR; PG8_SCHED;
            PG8_STAGE(PG8_SB(0, 1), b2 + hstep, voffB);
            PG8_WAIT_V(6); PG8_BAR; PG8_MMA(1, 1, At, B1); PG8_BAR;
            PG8_LDB(B0, 1, 0); PG8_SCHED; PG8_LDA(At, 1, 0); PG8_STAGE(PG8_SA(0, 1), a2 + hstep, voffA);
            PG8_WAIT_L(8); PG8_BAR; PG8_WAIT_L(0); PG8_MMA(0, 0, At, B0); PG8_BAR; PG8_SCHED;
            PG8_LDB(B1, 1, 1); PG8_STAGE(PG8_SB(1, 0), b3, voffB);
            PG8_BAR; PG8_WAIT_L(0); PG8_MMA(0, 1, At, B1); PG8_BAR;
            PG8_LDA(At, 1, 1); PG8_STAGE(PG8_SA(1, 0), a3, voffA);
            PG8_BAR; PG8_WAIT_L(0); PG8_MMA(1, 0, At, B0); PG8_BAR; PG8_SCHED;
            PG8_STAGE(PG8_SB(1, 1), b3 + hstep, voffB);
            PG8_WAIT_V(6); PG8_BAR; PG8_MMA(1, 1, At, B1); PG8_BAR;
            }
        }
        if constexpr (ALIGN_EPI) { if (wr == 0) PG8_BAR; }
        if constexpr (!Epi::AFTER_DRAIN) { E(acc, cur, wr, wc, fr, fq); S.done(cur); }
        if (!has_next) break;
#pragma unroll
        for (int a = 0; a < 2; ++a)
#pragma unroll
            for (int b = 0; b < 2; ++b)
#pragma unroll
                for (int m = 0; m < 4; ++m)
#pragma unroll
                    for (int n = 0; n < 2; ++n) acc[a][b][m][n] = (f32x4){0.f, 0.f, 0.f, 0.f};
        cur = nxt; cA = nA; cB = nB; ++ui;
        if constexpr (ALIGN_EPI) { if (wr == 1) PG8_BAR; }
    }
    PG8_WAIT_V(0);
    if constexpr (!ALIGN_EPI) { if (wr == 0) PG8_BAR; }
    PG8_BAR;
    if constexpr (Epi::AFTER_DRAIN) { E.fused(acc, cur, wr, wc, fr, fq, lds, wid, lane); S.done(cur); }
#undef PG8_SA
#undef PG8_SB
#undef PG8_STAGE
#undef PG8_LDA
#undef PG8_LDB
#undef PG8_MMA
#undef PG8_WAIT_V
#undef PG8_WAIT_L
#undef PG8_BAR
#undef PG8_SCHED
}
}

#define LAS __attribute__((address_space(3)))
typedef unsigned short bf16;
typedef short bf16x8 __attribute__((ext_vector_type(8)));
typedef float f32x4 __attribute__((ext_vector_type(4)));
typedef unsigned u32x4v __attribute__((ext_vector_type(4)));
typedef unsigned u32x2v __attribute__((ext_vector_type(2)));

constexpr int D = 1024, DIN = 2304, DFF = 4096, MTOT = 49152, MP = 32768, MODW = 6144;
constexpr int CHUNK_ROWS = 16384, NCHUNK = 3;
constexpr float EPS = 1e-6f, LOG2E = 1.4426950408889634f, QSCALE = 0.125f * 1.4426950408889634f;
constexpr int LDS_BAR_OFF = 153344;
constexpr int LDS_BYTES = 153600;
constexpr size_t WS_BAR = 0;
constexpr size_t MiB = 1u << 20;
constexpr size_t WS_WIN = 1 * MiB, WS_WOUT = 10 * MiB, WS_WFF1 = 14 * MiB, WS_WFF2 = 30 * MiB, WS_MOD = 46 * MiB, WS_ROPE = 47 * MiB;
constexpr size_t WS_H = 48 * MiB, WS_PROJ = 144 * MiB, WS_MIX = 360 * MiB, WS_FFH = 144 * MiB;
constexpr size_t WS_RSS = 46 * MiB + 256 * 1024  , WS_SW = 64 * 1024  ;
constexpr size_t FFH_BYTES = 128 * MiB;
constexpr size_t WS_VF = WS_H  , WS_KF = 456 * MiB, WS_END = 504 * MiB;

struct Params {
    const float *x_prompt, *x_sample, *c_prompt, *c_sample, *norm1_g, *norm2_g, *w_ada, *b_ada, *w_in, *qa_g, *ka_g, *a_sink, *bv_g, *w_sp, *b_sp,
        *qc_g, *kc_g, *rel_bias, *w_out, *w_ff1, *w_ff2;
    float* out; unsigned char* ws;
};

__device__ __forceinline__ float bf_lo(unsigned w) { return __uint_as_float(w << 16); }
__device__ __forceinline__ float bf_hi(unsigned w) { return __uint_as_float(w & 0xffff0000u); }
__device__ __forceinline__ unsigned pack2(float lo, float hi) { return pg8::cvt_pk_bf16(lo, hi); }
__device__ __forceinline__ float wave_sum(float v) {
#pragma unroll
    for (int o = 1; o < 64; o <<= 1) v += __shfl_xor(v, o);
    return v;
}
__device__ __forceinline__ float gelu_tanh(float x) {
    const float u = 0.7978845608028654f * (x + 0.044715f * x * x * x);
    return x * __builtin_amdgcn_rcpf(1.f + __builtin_amdgcn_exp2f(-2.f * LOG2E * u));
}
template <int CTRL> __device__ __forceinline__ float dpp_f(float v) { return __builtin_bit_cast(float, __builtin_amdgcn_update_dpp(0, __builtin_bit_cast(int, v), CTRL, 0xf, 0xf, false)); }
__device__ __forceinline__ float sum16(float s) {
    s += dpp_f<0xB1>(s); s += dpp_f<0x4E>(s); s += dpp_f<0x141>(s); s += dpp_f<0x140>(s); return s;
}
__device__ __forceinline__ f32x4 mfma16(bf16x8 a, bf16x8 b, f32x4 c) { return __builtin_amdgcn_mfma_f32_16x16x32_bf16(a, b, c, 0, 0, 0); }

__device__ __forceinline__ void transpose_item(const float* W, int K, int N, bf16* WT, LAS float* scr, int item, int lane) {
    const int nblk = N / 32, kb = item / nblk, nb = item % nblk, k0 = 64 * kb, n0 = 32 * nb;
#pragma unroll 8
    for (int i = 0; i < 32; ++i) { const int kk = 2 * i + (lane >> 5); scr[kk * 33 + (lane & 31)] = W[(size_t)(k0 + kk) * N + n0 + (lane & 31)]; }
    asm volatile("s_waitcnt lgkmcnt(0)" ::: "memory");
    const int c = lane & 7;
#pragma unroll
    for (int j = 0; j < 4; ++j) { const int n = (lane >> 3) + 8 * j; const LAS float* s = scr + (8 * c) * 33 + n;
        u32x4v o; o.x = pack2(s[0 * 33], s[1 * 33]); o.y = pack2(s[2 * 33], s[3 * 33]); o.z = pack2(s[4 * 33], s[5 * 33]); o.w = pack2(s[6 * 33], s[7 * 33]);
        *(u32x4v*)(WT + (size_t)(n0 + n) * K + k0 + 8 * c) = o; }
    asm volatile("s_waitcnt lgkmcnt(0)" ::: "memory");
}

__device__ __forceinline__ int vopaque(int v) { asm volatile("" : "+v"(v)); return v; }
__device__ __forceinline__ int sopaque(int v) { asm volatile("" : "+s"(v)); return v; }
typedef const __attribute__((address_space(4))) Params* KPtr;
__device__ __forceinline__ KPtr kopaque(KPtr q) { asm volatile("" : "+s"(q)); return q; }
template <int SEL> __device__ __forceinline__ void transposes(KPtr kp, LAS unsigned char* lds, int gw, int NGW, int wave, int lane) {
    KPtr p = kopaque(kp); unsigned char* ws = p->ws;
    LAS float* scr = (LAS float*)(lds + wave * 16384);
    constexpr int I_IN = 16 * 72, I_OUT = 16 * 32, I_F1 = 16 * 128, I_F2 = 64 * 32;
    if (SEL == 0) { for (int it = gw; it < 2 * I_IN; it += NGW) { const int l = it / I_IN, r = it % I_IN;
        transpose_item(p->w_in + (size_t)l * D * DIN, D, DIN, (bf16*)(ws + WS_WIN) + (size_t)l * DIN * D, scr, r, lane); } }
    if (SEL == 1) { for (int it = gw; it < 2 * I_OUT; it += NGW) { const int l = it / I_OUT, r = it % I_OUT;
        transpose_item(p->w_out + (size_t)l * D * D, D, D, (bf16*)(ws + WS_WOUT) + (size_t)l * D * D, scr, r, lane); } }
    if (SEL == 2) { for (int it = gw; it < 2 * (I_F1 + I_F2); it += NGW) { const int l = it / (I_F1 + I_F2), r = it % (I_F1 + I_F2);
        if (r < I_F1) transpose_item(p->w_ff1 + (size_t)l * D * DFF, D, DFF, (bf16*)(ws + WS_WFF1) + (size_t)l * DFF * D, scr, r, lane);
        else transpose_item(p->w_ff2 + (size_t)l * DFF * D, DFF, D, (bf16*)(ws + WS_WFF2) + (size_t)l * D * DFF, scr, r - I_F1, lane); } }
}
__device__ __forceinline__ void phase0a(KPtr kp, LAS unsigned char* lds, int tid, int wave, int lane) {
    KPtr p = kopaque(kp); unsigned char* ws = p->ws;
    {
        float* z0 = (float*)(ws + WS_MOD); float* z1 = (float*)(ws + WS_SW);
        for (int i = blockIdx.x * 512 + tid; i < (1 << 18); i += gridDim.x * 512) z0[i] = 0.f;
        for (int i = blockIdx.x * 512 + tid; i < 4 * 5 * 4096; i += gridDim.x * 512) z1[i] = 0.f;
    }
    {
        float* rc = (float*)(ws + WS_ROPE); float* rs = rc + 16384 * 8;
        for (int i = blockIdx.x * 512 + tid; i < 16384 * 8; i += gridDim.x * 512) {
            const int pos = i >> 3, f = i & 7;
            const float inv = f == 0 ? 1.0f : f == 1 ? 0.19392274474868576f : f == 2 ? 0.03760603093086393f : f == 3 ? 0.007292664737217109f :
                              f == 4 ? 0.001414213562373095f : f == 5 ? 0.0002742481756762073f : f == 6 ? 5.318295896944988e-05f : 1.031338537721246e-05f;
            const float ang = (float)pos * inv;
            double rev = (double)ang * 0.15915494309189535; rev -= __builtin_floor(rev);
            rc[i] = __builtin_amdgcn_cosf((float)rev); rs[i] = __builtin_amdgcn_sinf((float)rev);
        }
    }
    transposes<0>(kp, lds, blockIdx.x * 8 + wave, gridDim.x * 8, wave, lane);
}
__device__ __forceinline__ void phase0b(KPtr kp, LAS unsigned char* lds, int gw, int NGW, int wave, int lane) {
    KPtr p = kopaque(kp); unsigned char* ws = p->ws;
    float* mod = (float*)(ws + WS_MOD);
    LAS float* sl = (LAS float*)(lds + wave * 16384);
    for (int item = gw; item < 1536; item += NGW) {
        const int ks = item & 7, r = item >> 3, l = r / 96, col0 = (r % 96) * 64;
        for (int i = lane; i < 640; i += 64) { const int b = i >> 7, k = ks * 128 + (i & 127); const float c = (b < 4) ? p->c_prompt[b * 1024 + k] : p->c_sample[k];
            sl[i] = c * __builtin_amdgcn_rcpf(1.f + __expf(-c)); }
        asm volatile("s_waitcnt lgkmcnt(0)" ::: "memory");
        const float* W = p->w_ada + (size_t)l * 1024 * MODW + (size_t)ks * 128 * MODW + col0 + lane;
        float a0 = 0.f, a1 = 0.f, a2 = 0.f, a3 = 0.f, a4 = 0.f;
#pragma unroll 16
        for (int kk = 0; kk < 128; ++kk) { const float w = W[(size_t)kk * MODW];
            a0 += sl[kk] * w; a1 += sl[128 + kk] * w; a2 += sl[256 + kk] * w; a3 += sl[384 + kk] * w; a4 += sl[512 + kk] * w; }
        if (ks == 0) { const float bb = p->b_ada[l * MODW + col0 + lane]; a0 += bb; a1 += bb; a2 += bb; a3 += bb; a4 += bb; }
        float* m = mod + (size_t)(l * 5) * MODW + col0 + lane;
        __hip_atomic_fetch_add(m, a0, __ATOMIC_RELAXED, __HIP_MEMORY_SCOPE_AGENT); __hip_atomic_fetch_add(m + MODW, a1, __ATOMIC_RELAXED, __HIP_MEMORY_SCOPE_AGENT);
        __hip_atomic_fetch_add(m + 2 * MODW, a2, __ATOMIC_RELAXED, __HIP_MEMORY_SCOPE_AGENT); __hip_atomic_fetch_add(m + 3 * MODW, a3, __ATOMIC_RELAXED, __HIP_MEMORY_SCOPE_AGENT);
        __hip_atomic_fetch_add(m + 4 * MODW, a4, __ATOMIC_RELAXED, __HIP_MEMORY_SCOPE_AGENT);
        asm volatile("s_waitcnt lgkmcnt(0)" ::: "memory");
    }
    transposes<1>(kp, lds, gw, NGW, wave, lane);
}

__device__ __forceinline__ void xa_phase(const float* xa, const float* xb, int split, const float* g, const float* scale  , bf16* H, float* rss, int gw, int NGW, int lane_in) {
    const int lane = vopaque(lane_in);
    f32x4 vn[4];
    if (gw < MTOT) { const float* xrow = (gw < split) ? xa + (size_t)gw * D : xb + (size_t)(gw - split) * D; const f32x4* xr = (const f32x4*)xrow + lane;
#pragma unroll
        for (int j = 0; j < 4; ++j) vn[j] = xr[64 * j]; }
    for (int m = gw; m < MTOT; m += NGW) {
        int b = m >> 13; b = b > 4 ? 4 : b;
        f32x4 v[4]; float ss = 0.f;
#pragma unroll
        for (int j = 0; j < 4; ++j) { v[j] = vn[j]; ss += (v[j].x * v[j].x + v[j].y * v[j].y) + (v[j].z * v[j].z + v[j].w * v[j].w); }
        const int mn = m + NGW;
        if (mn < MTOT) { const float* xrow = (mn < split) ? xa + (size_t)mn * D : xb + (size_t)(mn - split) * D; const f32x4* xr = (const f32x4*)xrow + lane;
#pragma unroll
            for (int j = 0; j < 4; ++j) vn[j] = xr[64 * j]; }
        f32x4 gg[4], sc[4];
#pragma unroll
        for (int j = 0; j < 4; ++j) { const int col = 256 * j + 4 * lane; gg[j] = *(const f32x4*)(g + col); sc[j] = *(const f32x4*)(scale + (size_t)b * MODW + col); }
        __builtin_amdgcn_sched_barrier(0);
        ss = wave_sum(ss);
        if (lane == 0) rss[m] = ss;
        u32x2v* o = (u32x2v*)(H + (size_t)m * D) + lane;
#pragma unroll
        for (int j = 0; j < 4; ++j) {
            const f32x4 y = v[j] * gg[j] * (sc[j] + 1.f);
            u32x2v w; w.x = pack2(y.x, y.y); w.y = pack2(y.z, y.w); o[64 * j] = w; }
    }
}
__device__ __forceinline__ void sw_phase(const float* mod, const float* w_in, const float* w_ff1, float* sW, LAS unsigned char* lds, int gw, int NGW, int wave, int lane) {
    LAS float* sl = (LAS float*)(lds + wave * 16384);
    for (int item = gw; item < 1600; item += NGW) {
        const int ks = item & 7, r0 = item >> 3, l = r0 / 100, r = r0 % 100, which = r < 36 ? 0 : 1, cc = which ? r - 36 : r, N = which ? DFF : DIN, col0 = cc * 64;
        const float* sh = mod + (size_t)l * 5 * MODW + (which ? 3 * D : 0) + ks * 128;
        for (int i = lane; i < 640; i += 64) sl[i] = sh[(size_t)(i >> 7) * MODW + (i & 127)];
        asm volatile("s_waitcnt lgkmcnt(0)" ::: "memory");
        const float* W = (which ? w_ff1 + (size_t)l * D * DFF : w_in + (size_t)l * D * DIN) + (size_t)ks * 128 * N + col0 + lane;
        float a0 = 0.f, a1 = 0.f, a2 = 0.f, a3 = 0.f, a4 = 0.f;
#pragma unroll 16
        for (int kk = 0; kk < 128; ++kk) { const float w = W[(size_t)kk * N];
            a0 += sl[kk] * w; a1 += sl[128 + kk] * w; a2 += sl[256 + kk] * w; a3 += sl[384 + kk] * w; a4 += sl[512 + kk] * w; }
        float* o = sW + ((size_t)(l * 2 + which) * 5) * 4096 + col0 + lane;
        __hip_atomic_fetch_add(o, a0, __ATOMIC_RELAXED, __HIP_MEMORY_SCOPE_AGENT); __hip_atomic_fetch_add(o + 4096, a1, __ATOMIC_RELAXED, __HIP_MEMORY_SCOPE_AGENT);
        __hip_atomic_fetch_add(o + 2 * 4096, a2, __ATOMIC_RELAXED, __HIP_MEMORY_SCOPE_AGENT); __hip_atomic_fetch_add(o + 3 * 4096, a3, __ATOMIC_RELAXED, __HIP_MEMORY_SCOPE_AGENT);
        __hip_atomic_fetch_add(o + 4 * 4096, a4, __ATOMIC_RELAXED, __HIP_MEMORY_SCOPE_AGENT);
        asm volatile("s_waitcnt lgkmcnt(0)" ::: "memory");
    }
}

__device__ __forceinline__ int prep_unit(int gidx, int grp) { return gidx == 0 ? 6 + grp : gidx == 1 ? 14 + grp : 24 + (gidx - 2) * 4 + grp; }
__device__ __forceinline__ void prep_task(int task, const bf16* P, bf16* KF, bf16* VF, const float* ka_g, const float* bv_g, const float* kc_g,
                                          const float* ropeC, const float* ropeS, LAS unsigned char* wlds, int lane) {
    const int tb = task / 5, gidx = task % 5;
    const int sub = lane & 15, grp = lane >> 4;
    const int u = prep_unit(gidx, grp);
    const bool isk = (u >= 6 && u < 8) || (u >= 24 && u < 30), isbv = (u >= 14 && u < 18);
    const bool isv = !isk;
    const bf16* base = P + (size_t)tb * 16 * DIN + u * 64 + 4 * sub;
    const float* gp = (u < 8) ? ka_g : kc_g;
    const f32x4 gg = *(const f32x4*)(gp + 4 * sub);
    f32x4 g2 = {1.f, 1.f, 1.f, 1.f};
    if (isbv) g2 = *(const f32x4*)(bv_g + (u - 14) * 64 + 4 * sub);
    const int m0 = tb * 16, pos0 = (m0 < MP) ? (m0 & 8191) : (m0 - MP);
    LAS unsigned char* reg = wlds + grp * 2048;
    const int c = sub >> 1;
    u32x2v rawn[4];
#pragma unroll
    for (int j = 0; j < 4; ++j) rawn[j] = *(const u32x2v*)(base + (size_t)j * DIN);
#pragma unroll 1
    for (int tq4 = 0; tq4 < 4; ++tq4) {
        u32x2v raw[4];
#pragma unroll
        for (int j = 0; j < 4; ++j) raw[j] = rawn[j];
        if (tq4 < 3) {
#pragma unroll
            for (int j = 0; j < 4; ++j) rawn[j] = *(const u32x2v*)(base + (size_t)(4 * tq4 + 4 + j) * DIN);
        }
        float vk[4][4];
#pragma unroll
        for (int j = 0; j < 4; ++j) {
            const int tk = 4 * tq4 + j;
            float x[4] = {bf_lo(raw[j].x), bf_hi(raw[j].x), bf_lo(raw[j].y), bf_hi(raw[j].y)};
            float o[4];
            if (gidx == 1) {
                float sq = sum16((x[0] * x[0] + x[1] * x[1]) + (x[2] * x[2] + x[3] * x[3])); sq += __shfl_xor(sq, 16); sq += __shfl_xor(sq, 32);
                const float r2 = __builtin_amdgcn_rsqf(sq * (1.f / 256.f) + EPS);
                o[0] = x[0] * r2 * g2.x; o[1] = x[1] * r2 * g2.y; o[2] = x[2] * r2 * g2.z; o[3] = x[3] * r2 * g2.w;
            } else if (gidx == 4) {
#pragma unroll
                for (int i = 0; i < 4; ++i) o[i] = x[i];
            } else {
                float ss = sum16((x[0] * x[0] + x[1] * x[1]) + (x[2] * x[2] + x[3] * x[3]));
                const float rinv = __builtin_amdgcn_rsqf(ss * (1.f / 64.f) + EPS);
                float y[4] = {x[0] * rinv * gg.x, x[1] * rinv * gg.y, x[2] * rinv * gg.z, x[3] * rinv * gg.w};
                if (gidx == 0) {
                    float yp[4];
#pragma unroll
                    for (int i = 0; i < 4; ++i) yp[i] = dpp_f<0x4E>(y[i]);
                    if (sub < 4) {
                        const f32x4 c4 = *(const f32x4*)(ropeC + (pos0 + tk) * 8 + 4 * (sub & 1)), s4 = *(const f32x4*)(ropeS + (pos0 + tk) * 8 + 4 * (sub & 1));
                        const float sg = (sub < 2) ? -1.f : 1.f;
                        y[0] = y[0] * c4.x + sg * yp[0] * s4.x; y[1] = y[1] * c4.y + sg * yp[1] * s4.y; y[2] = y[2] * c4.z + sg * yp[2] * s4.z; y[3] = y[3] * c4.w + sg * yp[3] * s4.w;
                    }
                }
#pragma unroll
                for (int i = 0; i < 4; ++i) o[i] = isk ? y[i] : x[i];
            }
            if (isk) { u32x2v w; w.x = pack2(o[0], o[1]); w.y = pack2(o[2], o[3]);
                *(LAS u32x2v*)(reg + (c * 16 + (tk ^ c)) * 16 + (sub & 1) * 8) = w; }
#pragma unroll
            for (int i = 0; i < 4; ++i) vk[j][i] = o[i];
        }
        if (isv) {
#pragma unroll
            for (int i = 0; i < 4; ++i) { const int d = 4 * sub + i;
                u32x2v w; w.x = pack2(vk[0][i], vk[1][i]); w.y = pack2(vk[2][i], vk[3][i]);
                *(LAS u32x2v*)(reg + (((d >> 4) * 4 + tq4) * 16 + (d & 15)) * 8) = w; }
        }
    }
    asm volatile("s_waitcnt lgkmcnt(0)" ::: "memory");
#pragma unroll
    for (int r = 0; r < 4; ++r) {
        const int ur = prep_unit(gidx, r);
        const bool rk = (ur >= 6 && ur < 8) || (ur >= 24 && ur < 30), rv = (ur >= 8 && ur < 10) || (ur >= 14 && ur < 18) || (ur >= 30);
        if (rk) {
            const int kh = (ur < 8) ? (ur - 6) : (ur - 22);
            bf16* dst = KF + ((size_t)tb * 8 + kh) * 1024 + lane * 8;
            const int c0 = lane >> 4, f0 = lane & 15;
            const u32x4v d0 = *(const LAS u32x4v*)(wlds + r * 2048 + (c0 * 16 + (f0 ^ c0)) * 16);
            const u32x4v d1 = *(const LAS u32x4v*)(wlds + r * 2048 + ((c0 + 4) * 16 + (f0 ^ (c0 + 4))) * 16);
            *(u32x4v*)dst = d0; *(u32x4v*)(dst + 512) = d1;
        } else if (rv) {
            const int vh = (ur < 10) ? (ur - 8) : (ur < 18) ? (ur - 12) : (ur - 24);
            bf16* dst = VF + ((size_t)tb * 12 + vh) * 1024 + lane * 8;
            const u32x4v d0 = *(const LAS u32x4v*)(wlds + r * 2048 + lane * 16), d1 = *(const LAS u32x4v*)(wlds + r * 2048 + 1024 + lane * 16);
            *(u32x4v*)dst = d0; *(u32x4v*)(dst + 512) = d1;
        }
    }
    asm volatile("s_waitcnt lgkmcnt(0)" ::: "memory");
}

__device__ __forceinline__ bf16x8 vf_frag(const bf16* p0, const bf16* p1) {
    const u32x2v lo = *(const u32x2v*)p0, hi = *(const u32x2v*)p1;
    u32x4v w; w.x = lo.x; w.y = lo.y; w.z = hi.x; w.w = hi.y; return __builtin_bit_cast(bf16x8, w);
}
__device__ __forceinline__ bf16x8 pack_p(const f32x4& a, const f32x4& b) {
    u32x4v w; w.x = pack2(a.x, a.y); w.y = pack2(a.z, a.w); w.z = pack2(b.x, b.y); w.w = pack2(b.z, b.w); return __builtin_bit_cast(bf16x8, w);
}

__device__ __forceinline__ void dma1k(const bf16* gsrc_lane, LAS unsigned char* ldst) {
    __builtin_amdgcn_global_load_lds((const unsigned*)gsrc_lane, (LAS unsigned*)ldst, 16, 0, 0);
}
__device__ __forceinline__ bf16x8 lds_vfrag(const LAS unsigned char* p0, const LAS unsigned char* p1) {
    const u32x2v lo = *(const LAS u32x2v*)p0, hi = *(const LAS u32x2v*)p1;
    u32x4v w; w.x = lo.x; w.y = lo.y; w.z = hi.x; w.w = hi.y; return __builtin_bit_cast(bf16x8, w);
}

template <bool ROPE> __device__ __forceinline__ void q_prep(bf16x8& q0, bf16x8& q1, const float* g, const float* ropeC, const float* ropeS, int pos, int fq) {
    const u32x4v a = __builtin_bit_cast(u32x4v, q0), b = __builtin_bit_cast(u32x4v, q1);
    float x0[8] = {bf_lo(a.x), bf_hi(a.x), bf_lo(a.y), bf_hi(a.y), bf_lo(a.z), bf_hi(a.z), bf_lo(a.w), bf_hi(a.w)};
    float x1[8] = {bf_lo(b.x), bf_hi(b.x), bf_lo(b.y), bf_hi(b.y), bf_lo(b.z), bf_hi(b.z), bf_lo(b.w), bf_hi(b.w)};
    float ss = 0.f;
#pragma unroll
    for (int j = 0; j < 8; ++j) ss += x0[j] * x0[j] + x1[j] * x1[j];
    ss += __shfl_xor(ss, 16); ss += __shfl_xor(ss, 32);
    const float sc = __builtin_amdgcn_rsqf(ss * (1.f / 64.f) + EPS) * QSCALE;
    const f32x4 g0a = *(const f32x4*)(g + 8 * fq), g0b = *(const f32x4*)(g + 8 * fq + 4), g1a = *(const f32x4*)(g + 32 + 8 * fq), g1b = *(const f32x4*)(g + 36 + 8 * fq);
    const float gv0[8] = {g0a.x, g0a.y, g0a.z, g0a.w, g0b.x, g0b.y, g0b.z, g0b.w}, gv1[8] = {g1a.x, g1a.y, g1a.z, g1a.w, g1b.x, g1b.y, g1b.z, g1b.w};
#pragma unroll
    for (int j = 0; j < 8; ++j) { x0[j] *= sc * gv0[j]; x1[j] *= sc * gv1[j]; }
    if (ROPE) {
        float pr[8];
#pragma unroll
        for (int j = 0; j < 8; ++j) pr[j] = __shfl_xor(x0[j], 16);
        if (fq < 2) {
            const f32x4 ca = *(const f32x4*)(ropeC + pos * 8), cb = *(const f32x4*)(ropeC + pos * 8 + 4), sa = *(const f32x4*)(ropeS + pos * 8), sb = *(const f32x4*)(ropeS + pos * 8 + 4);
            const float cv[8] = {ca.x, ca.y, ca.z, ca.w, cb.x, cb.y, cb.z, cb.w}, sv[8] = {sa.x, sa.y, sa.z, sa.w, sb.x, sb.y, sb.z, sb.w};
            const float sg = (fq == 0) ? -1.f : 1.f;
#pragma unroll
            for (int j = 0; j < 8; ++j) x0[j] = x0[j] * cv[j] + sg * pr[j] * sv[j];
        }
    }
    u32x4v oa, ob;
    oa.x = pack2(x0[0], x0[1]); oa.y = pack2(x0[2], x0[3]); oa.z = pack2(x0[4], x0[5]); oa.w = pack2(x0[6], x0[7]);
    ob.x = pack2(x1[0], x1[1]); ob.y = pack2(x1[2], x1[3]); ob.z = pack2(x1[4], x1[5]); ob.w = pack2(x1[6], x1[7]);
    q0 = __builtin_bit_cast(bf16x8, oa); q1 = __builtin_bit_cast(bf16x8, ob);
}

__device__ __forceinline__ void mixer_b_task(int task, const bf16* P, const bf16* VF, bf16* MIX, const float* w_sp, const float* b_sp, int lane);
__device__ __forceinline__ void mixer_a_item(int idx, const bf16* P, const bf16* KF, const bf16* VF, bf16* MIX, const float* sink, const float* qg, const float* ropeC, LAS unsigned char* lds, int wave, int lane, int btask, const float* w_sp, const float* b_sp) {
    const int blkg = idx >> 1, kvh = idx & 1;
    int n, S, row0;
    if (blkg < 256) { n = blkg & 63; S = 8192; row0 = (blkg >> 6) * 8192; } else { n = blkg - 256; S = 16384; row0 = MP; }
    const int tb0 = (row0 >> 4) + 8 * (n - 1), tblo = row0 >> 4, tbhi = ((row0 + S) >> 4) - 1;
    LAS unsigned char* Kl = lds; LAS unsigned char* Vl = lds + 49152;
#pragma unroll 1
    for (int j = 0; j < 12; ++j) {
        const int i = wave + 8 * j, which = i / 48, rem = i % 48, blk = rem >> 1, half = rem & 1;
        int tb = tb0 + blk; tb = tb < tblo ? tblo : tb; tb = tb > tbhi ? tbhi : tb;
        const bf16* src = which ? VF + ((size_t)tb * 12 + kvh) * 1024 + half * 512 + lane * 8 : KF + ((size_t)tb * 8 + kvh) * 1024 + half * 512 + lane * 8;
        dma1k(src, (which ? Vl : Kl) + blk * 2048 + half * 1024);
    }
    const int fr = lane & 15, fq = lane >> 4;
    const int tq = row0 + 128 * n + 16 * wave;
    bf16x8 qf[3][2];
#pragma unroll
    for (int g = 0; g < 3; ++g) { const bf16* qp = P + (size_t)(tq + fr) * DIN + (kvh * 3 + g) * 64 + 8 * fq; qf[g][0] = *(const bf16x8*)qp; qf[g][1] = *(const bf16x8*)(qp + 32); }
#pragma unroll
    for (int g = 0; g < 3; ++g) q_prep<true>(qf[g][0], qf[g][1], qg, ropeC, ropeC + 16384 * 8, 128 * n + 16 * wave + fr, fq);
    if (btask < 12288) mixer_b_task(btask, P, VF, MIX, w_sp, b_sp, lane);
    asm volatile("s_waitcnt vmcnt(0)" ::: "memory");
    __syncthreads();
#pragma unroll 1
    for (int g = 0; g < 3; ++g) {
        const int head = kvh * 3 + g;
        const bf16x8 q0 = g == 0 ? qf[0][0] : g == 1 ? qf[1][0] : qf[2][0], q1 = g == 0 ? qf[0][1] : g == 1 ? qf[1][1] : qf[2][1];
        f32x4 s[18];
#pragma unroll
        for (int kb = 0; kb < 17; ++kb) {
            int blk = wave + kb; blk = blk > 23 ? 23 : blk;
            const LAS unsigned char* kp = Kl + blk * 2048 + lane * 16;
            const bf16x8 k0 = *(const LAS bf16x8*)kp, k1 = *(const LAS bf16x8*)(kp + 1024);
            f32x4 acc = {0.f, 0.f, 0.f, 0.f};
            acc = mfma16(k0, q0, acc); acc = mfma16(k1, q1, acc); s[kb] = acc;
        }
        const float sk2 = sink[head] * LOG2E;
        float mx = sk2;
#pragma unroll
        for (int kb = 0; kb < 17; ++kb)
#pragma unroll
            for (int i = 0; i < 4; ++i) {
                const int rel = 16 * kb + 4 * fq + i - fr;
                const int kpos = 128 * (n - 1) + (wave + kb) * 16 + 4 * fq + i;
                const bool ok = rel >= 0 && rel <= 256 && kpos >= 0 && kpos < S;
                const float v = ok ? s[kb][i] : -1e30f; s[kb][i] = v; mx = fmaxf(mx, v);
            }
        mx = fmaxf(mx, __shfl_xor(mx, 16)); mx = fmaxf(mx, __shfl_xor(mx, 32));
        float sum = 0.f;
#pragma unroll
        for (int kb = 0; kb < 17; ++kb)
#pragma unroll
            for (int i = 0; i < 4; ++i) { const float pe = __builtin_amdgcn_exp2f(s[kb][i] - mx); s[kb][i] = pe; sum += pe; }
        s[17] = (f32x4){0.f, 0.f, 0.f, 0.f};
        sum += __shfl_xor(sum, 16); sum += __shfl_xor(sum, 32);
        const float inv = 1.f / (sum + __builtin_amdgcn_exp2f(sk2 - mx));
        f32x4 o[4];
#pragma unroll
        for (int db = 0; db < 4; ++db) o[db] = (f32x4){0.f, 0.f, 0.f, 0.f};
#pragma unroll
        for (int pp = 0; pp < 9; ++pp) {
            const bf16x8 pb = pack_p(s[2 * pp], s[2 * pp + 1]);
            int b0 = wave + 2 * pp, b1 = b0 + 1; b0 = b0 > 23 ? 23 : b0; b1 = b1 > 23 ? 23 : b1;
#pragma unroll
            for (int db = 0; db < 4; ++db) o[db] = mfma16(lds_vfrag(Vl + b0 * 2048 + db * 512 + lane * 8, Vl + b1 * 2048 + db * 512 + lane * 8), pb, o[db]);
        }
        bf16* op = MIX + (size_t)(tq + fr) * D + head * 64 + 4 * fq;
#pragma unroll
        for (int db = 0; db < 4; ++db) { const f32x4 v = o[db] * inv; u32x2v wv_; wv_.x = pack2(v.x, v.y); wv_.y = pack2(v.z, v.w); *(u32x2v*)(op + 16 * db) = wv_; }
    }
    __syncthreads();
}

__device__ __forceinline__ void mixer_c_item(int idx, const bf16* P, const bf16* KF, const bf16* VF, bf16* MIX, const float* rel_bias, const float* qg, LAS unsigned char* lds, int tid, int wave, int lane, int btask, const float* w_sp, const float* b_sp) {
    const int rp = idx / 6, h = idx % 6;
    int r0, rows, tok0;
    if (rp < 256) { r0 = 2 * (rp & 63); rows = 128; tok0 = (rp >> 6) * 8192; } else { r0 = 2 * (rp - 256); rows = 256; tok0 = MP; }
    int rs0 = r0 - 4; rs0 = rs0 < 0 ? 0 : rs0; rs0 = rs0 > rows - 8 ? rows - 8 : rs0;
    LAS unsigned char* Kl = lds; LAS unsigned char* Vl = lds + 73728; LAS float* biasL = (LAS float*)(lds + 147456);
#pragma unroll 1
    for (int j = 0; j < 18; ++j) {
        const int i = wave + 8 * j, which = i / 72, rem = i % 72, blk = rem >> 1, half = rem & 1;
        int krow = rs0 + (blk >> 2); krow = krow > rows - 1 ? rows - 1 : krow;
        const int tb = (tok0 >> 4) + krow * 4 + (blk & 3);
        const bf16* src = which ? VF + ((size_t)tb * 12 + 6 + h) * 1024 + half * 512 + lane * 8 : KF + ((size_t)tb * 8 + 2 + h) * 1024 + half * 512 + lane * 8;
        dma1k(src, (which ? Vl : Kl) + blk * 2048 + half * 1024);
    }
    if (tid < 465) biasL[tid] = rel_bias[h * 465 + tid] * LOG2E;
    const int fr = lane & 15, fq = lane >> 4;
    const int r = r0 + (wave >> 2), j = wave & 3;
    int rs = r - 4; rs = rs < 0 ? 0 : rs; rs = rs > rows - 8 ? rows - 8 : rs;
    const int cb0 = j < 2 ? 0 : 1;
    const int qc = 16 * j + fr;
    const int tq = tok0 + r * 64 + 16 * j;
    int cs = qc - 8; cs = cs < 0 ? 0 : cs; cs = cs > 48 ? 48 : cs;
    const bf16* qp = P + (size_t)(tq + fr) * DIN + 1152 + h * 64 + 8 * fq;
    bf16x8 q0 = *(const bf16x8*)qp, q1 = *(const bf16x8*)(qp + 32);
    q_prep<false>(q0, q1, qg, nullptr, nullptr, 0, fq);
    if (btask < 12288) mixer_b_task(btask, P, VF, MIX, w_sp, b_sp, lane);
    asm volatile("s_waitcnt vmcnt(0)" ::: "memory");
    __syncthreads();
    const int lb0 = (rs - rs0) * 4 + cb0;
    f32x4 s[24];
#pragma unroll
    for (int kb = 0; kb < 24; ++kb) {
        const LAS unsigned char* kp = Kl + (lb0 + 4 * (kb / 3) + kb % 3) * 2048 + lane * 16;
        const bf16x8 k0 = *(const LAS bf16x8*)kp, k1 = *(const LAS bf16x8*)(kp + 1024);
        f32x4 acc = {0.f, 0.f, 0.f, 0.f};
        acc = mfma16(k0, q0, acc); acc = mfma16(k1, q1, acc); s[kb] = acc;
    }
    float mx = -1e30f;
#pragma unroll
    for (int kb = 0; kb < 24; ++kb) {
        const int kr = kb / 3, t = kb % 3;
        const int dr = rs + kr - r + 7;
#pragma unroll
        for (int i = 0; i < 4; ++i) {
            const int kc = 16 * (cb0 + t) + 4 * fq + i;
            const bool ok = kc >= cs && kc < cs + 16;
            int dc = kc - qc + 15; dc = dc < 0 ? 0 : dc; dc = dc > 30 ? 30 : dc;
            const float v = ok ? s[kb][i] + biasL[dr * 31 + dc] : -1e30f; s[kb][i] = v; mx = fmaxf(mx, v);
        }
    }
    mx = fmaxf(mx, __shfl_xor(mx, 16)); mx = fmaxf(mx, __shfl_xor(mx, 32));
    float sum = 0.f;
#pragma unroll
    for (int kb = 0; kb < 24; ++kb)
#pragma unroll
        for (int i = 0; i < 4; ++i) { const float pe = __builtin_amdgcn_exp2f(s[kb][i] - mx); s[kb][i] = pe; sum += pe; }
    sum += __shfl_xor(sum, 16); sum += __shfl_xor(sum, 32);
    const float inv = 1.f / sum;
    f32x4 o[4];
#pragma unroll
    for (int db = 0; db < 4; ++db) o[db] = (f32x4){0.f, 0.f, 0.f, 0.f};
#pragma unroll
    for (int pp = 0; pp < 12; ++pp) {
        const bf16x8 pb = pack_p(s[2 * pp], s[2 * pp + 1]);
        const int kb0 = 2 * pp, kb1 = 2 * pp + 1;
        const LAS unsigned char* v0 = Vl + (lb0 + 4 * (kb0 / 3) + kb0 % 3) * 2048 + lane * 8; const LAS unsigned char* v1 = Vl + (lb0 + 4 * (kb1 / 3) + kb1 % 3) * 2048 + lane * 8;
#pragma unroll
        for (int db = 0; db < 4; ++db) o[db] = mfma16(lds_vfrag(v0 + db * 512, v1 + db * 512), pb, o[db]);
    }
    bf16* op = MIX + (size_t)(tq + fr) * D + 640 + h * 64 + 4 * fq;
#pragma unroll
    for (int db = 0; db < 4; ++db) { const f32x4 v = o[db] * inv; u32x2v wv_; wv_.x = pack2(v.x, v.y); wv_.y = pack2(v.z, v.w); *(u32x2v*)(op + 16 * db) = wv_; }
    __syncthreads();
}

__device__ __forceinline__ void mixer_b_task(int task, const bf16* P, const bf16* VF, bf16* MIX, const float* w_sp, const float* b_sp, int lane) {
    const int g = task / 3072, p16 = task % 3072;
    const int fr = lane & 15, fq = lane >> 4;
    const int pt = (p16 & 7) * 16 + fr;
    const int tbc = p16 & ~7;
    const size_t tok = (size_t)p16 * 16 + fr;
    f32x4 wv[4][2];
#pragma unroll
    for (int ks = 0; ks < 4; ++ks) { const float* wp = w_sp + (size_t)(g * 128 + pt) * 128 + 32 * ks + 4 * fq; wv[ks][0] = *(const f32x4*)wp; wv[ks][1] = *(const f32x4*)(wp + 16); }
    const bf16* vfl = VF + ((size_t)tbc * 12 + 2 + g) * 1024 + lane * 4;
    bf16x8 vf[4][4];
#pragma unroll
    for (int ks = 0; ks < 4; ++ks)
#pragma unroll
        for (int eb = 0; eb < 4; ++eb) vf[ks][eb] = vf_frag(vfl + (size_t)(2 * ks) * 12288 + eb * 256, vfl + (size_t)(2 * ks + 1) * 12288 + eb * 256);
    u32x2v uus[4];
#pragma unroll
    for (int eb = 0; eb < 4; ++eb) uus[eb] = *(const u32x2v*)(P + tok * DIN + 640 + g * 64 + 16 * eb + 4 * fq);
    const float bias = b_sp[g * 128 + pt];
    f32x4 d[4];
#pragma unroll
    for (int eb = 0; eb < 4; ++eb) d[eb] = (f32x4){0.f, 0.f, 0.f, 0.f};
#pragma unroll
    for (int ks = 0; ks < 4; ++ks) {
        const bf16x8 bw = pack_p(wv[ks][0], wv[ks][1]);
#pragma unroll
        for (int eb = 0; eb < 4; ++eb) d[eb] = mfma16(vf[ks][eb], bw, d[eb]);
    }
#pragma unroll
    for (int eb = 0; eb < 4; ++eb) {
        const u32x2v uu = uus[eb];
        const float o0 = bf_lo(uu.x) * (d[eb].x + bias), o1 = bf_hi(uu.x) * (d[eb].y + bias), o2 = bf_lo(uu.y) * (d[eb].z + bias), o3 = bf_hi(uu.y) * (d[eb].w + bias);
        u32x2v w; w.x = pack2(o0, o1); w.y = pack2(o2, o3);
        *(u32x2v*)(MIX + tok * D + 384 + g * 64 + 16 * eb + 4 * fq) = w;
    }
}

#define XB_TMO      128
#define XB_XCNT(j)  (256  + 64 * (j))
#define XB_XSUB(j)  (1280 + 64 * (j))
#define XB_XGEN(j)  (2304 + 64 * (j))
#define XB_TOP      3328
#define XB_TOPGEN   3392
#define XCD_BAR_WORDS 3456
#define XB_SPIN_CAP (1u << 18)

__device__ __forceinline__ unsigned xb_ld(unsigned* p)              { return __hip_atomic_load(p, __ATOMIC_RELAXED, __HIP_MEMORY_SCOPE_AGENT); }
__device__ __forceinline__ unsigned xb_add(unsigned* p, unsigned v) { return __hip_atomic_fetch_add(p, v, __ATOMIC_RELAXED, __HIP_MEMORY_SCOPE_AGENT); }
__device__ __forceinline__ unsigned xb_xcc_id() { return (unsigned)__builtin_amdgcn_s_getreg((3 << 11) | 20) & 0xFu; }
#define XB_SPIN(cond, bar) do { unsigned _sp = 0; while (cond) { __builtin_amdgcn_s_sleep(1); \
    if ((++_sp & 255u) == 0u) { if (xb_ld(&(bar)[XB_TMO])) break; if (_sp > XB_SPIN_CAP) { atomicAdd(&(bar)[XB_TMO], 1u); break; } } } } while (0)

struct XcdBarrier {
    unsigned* bar; unsigned x;
    volatile LAS unsigned* st;
};

__device__ __forceinline__ XcdBarrier xcd_barrier_post(unsigned* bar, volatile LAS unsigned* st) {
    XcdBarrier b; b.bar = bar; b.x = xb_xcc_id(); b.st = st;
    if (threadIdx.x == 0) (void)xb_add(&bar[XB_XCNT(b.x)], 1u);
    return b;
}
__device__ __forceinline__ void xcd_barrier_complete(unsigned* bar, unsigned x, unsigned& nloc, unsigned& nx) {
    const unsigned G = gridDim.x * gridDim.y * gridDim.z;
    unsigned sum, cnt, mine, sp = 0u;
    for (;;) {
        sum = 0u; cnt = 0u; mine = 0u;
#pragma unroll
        for (unsigned j = 0; j < 16; ++j) { const unsigned c = xb_ld(&bar[XB_XCNT(j)]); sum += c; cnt += (c > 0u) ? 1u : 0u; mine = (j == x) ? c : mine; }
        if (sum == G) break;
        __builtin_amdgcn_s_sleep(1);
        if ((++sp & 255u) == 0u) { if (xb_ld(&bar[XB_TMO])) break; if (sp > XB_SPIN_CAP) { atomicAdd(&bar[XB_TMO], 1u); break; } }
    }
    nloc = mine > 0u ? mine : 1u; nx = cnt > 0u ? cnt : 1u;
}

__device__ __forceinline__ void xcd_barrier(const XcdBarrier& b) {
    asm volatile("s_waitcnt vmcnt(0)" ::: "memory");
    __syncthreads();
    if (threadIdx.x == 0) {
        unsigned* bar = b.bar;
        __builtin_amdgcn_s_waitcnt(0);
        unsigned nloc = b.st[0], nx = b.st[1];
        if (nloc == 0u) { xcd_barrier_complete(bar, b.x, nloc, nx); b.st[0] = nloc; b.st[1] = nx; }
        const unsigned old = xb_add(&bar[XB_XSUB(b.x)], 1u);
        const unsigned gen = old / nloc;
        if (old + 1u == (gen + 1u) * nloc) {
            __builtin_amdgcn_fence(__ATOMIC_RELEASE, "agent");
            asm volatile("s_waitcnt vmcnt(0)" ::: "memory");
            const unsigned og = xb_add(&bar[XB_TOP], 1u);
            const unsigned tg = og / nx;
            if (og + 1u == (tg + 1u) * nx) xb_add(&bar[XB_TOPGEN], 1u);
            else XB_SPIN(xb_ld(&bar[XB_TOPGEN]) == tg, bar);
            __builtin_amdgcn_fence(__ATOMIC_ACQUIRE, "agent");
            xb_add(&bar[XB_XGEN(b.x)], 1u);
            asm volatile("s_waitcnt vmcnt(0)" ::: "memory");
        } else {
            XB_SPIN(xb_ld(&bar[XB_XGEN(b.x)]) == gen, bar);
            __builtin_amdgcn_fence(__ATOMIC_ACQUIRE, "agent");
            asm volatile("s_waitcnt vmcnt(0)" ::: "memory");
        }
    }
    __syncthreads();
}
__global__ void __launch_bounds__(512, 2) fwd_kernel(Params p_unused) {
    extern __shared__ __attribute__((aligned(16))) unsigned char lds_raw[];
    cg::grid_group grid = cg::this_grid();
    KPtr kp = (KPtr)__builtin_amdgcn_kernarg_segment_ptr();
    LAS unsigned char* lds = (LAS unsigned char*)lds_raw;
    const int wave = __builtin_amdgcn_readfirstlane((int)threadIdx.x >> 6);
#define lane (lane_id_asm())
#define tid (wave * 64 + lane)
#define PH_IDS const int wv = sopaque(wave), bid = sopaque((int)blockIdx.x), G = sopaque((int)gridDim.x), gw = bid * 8 + wv, NGW = G * 8, vcu = (G % 8 == 0) ? (bid % 8) * (G / 8) + bid / 8 : bid, gwx = vcu * 8 + wv; (void)gw; (void)NGW; (void)wv; (void)gwx

    volatile LAS unsigned* bst = (volatile LAS unsigned*)(lds + LDS_BAR_OFF);
    if (tid < 64) bst[tid] = 0u;
    {
        KPtr q = kopaque(kp); unsigned* bw = (unsigned*)(q->ws + WS_BAR);
        if (blockIdx.x == 0) for (int i = tid; i < XCD_BAR_WORDS; i += 512) bw[i] = 0u;
    }
    __syncthreads();
    phase0a(kp, lds, tid, wave, lane);
    grid.sync();
    { KPtr q = kopaque(kp); (void)xcd_barrier_post((unsigned*)(q->ws + WS_BAR), bst); }
#define GRID_BAR() do { XcdBarrier b_; b_.bar = (unsigned*)(kopaque(kp)->ws + WS_BAR); b_.x = xb_xcc_id(); b_.st = (volatile LAS unsigned*)(lds + LDS_BAR_OFF); xcd_barrier(b_); } while (0)
    { PH_IDS; phase0b(kp, lds, gw, NGW, wv, lane); }
    GRID_BAR();

#pragma unroll 1
    for (int l = 0; l < 2; ++l) {
        if (l == 0) {
            PH_IDS; KPtr q = kopaque(kp); unsigned char* ws = q->ws;
            const float* mod = (const float*)(ws + WS_MOD);
            sw_phase(mod, q->w_in, q->w_ff1, (float*)(ws + WS_SW), lds, gw, NGW, wv, lane);
            xa_phase(q->x_prompt, q->x_sample, MP, q->norm1_g, mod + 1 * D, (bf16*)(ws + WS_H), (float*)(ws + WS_RSS), gw, NGW, lane);
            transposes<2>(kp, lds, gw, NGW, wv, lane);
            GRID_BAR();
        }
        {
            PH_IDS; KPtr q = kopaque(kp); unsigned char* ws = q->ws;
            pg8::Gemm g{(const bf16*)(ws + WS_H), (const bf16*)(ws + WS_WIN) + (size_t)l * DIN * D, MTOT, DIN, D}; pg8::StaticOrder S; S.init(MTOT, DIN, G, bid);
            pg8::EpiBf16N<0> E{(bf16*)(ws + WS_PROJ), DIN, (const float*)(ws + WS_RSS) + (size_t)(2 * l) * MTOT, (const float*)(ws + WS_SW) + (size_t)(2 * l) * 5 * 4096, 4096, 0, 640, 1152};
            pg8::gemm_phase<pg8::EpiBf16N<0>, pg8::StaticOrder, true, true>(lds, g, S, E, wv);
        }
        GRID_BAR();
        {
            PH_IDS; KPtr q = kopaque(kp); unsigned char* ws = q->ws;
            const float* ropeC = (const float*)(ws + WS_ROPE);
            bf16* PROJ = (bf16*)(ws + WS_PROJ); bf16* KF = (bf16*)(ws + WS_KF); bf16* VF = (bf16*)(ws + WS_VF);
            const float *ka = q->ka_g + l * 64, *bvg = q->bv_g + l * 256, *kc = q->kc_g + l * 64;
            const int lane_o = vopaque(tid) & 63;
#pragma unroll 1
            for (int task = gwx; task < 15360; task += NGW) prep_task(task, PROJ, KF, VF, ka, bvg, kc, ropeC, ropeC + 16384 * 8, lds + wv * 8192, lane_o);
            __syncthreads();
        }
        GRID_BAR();
        {
        {
            PH_IDS; KPtr q = kopaque(kp); unsigned char* ws = q->ws;
            const bf16* PROJ = (const bf16*)(ws + WS_PROJ); const bf16* KF = (const bf16*)(ws + WS_KF); const bf16* VF = (const bf16*)(ws + WS_VF); bf16* MIXB = (bf16*)(ws + WS_MIX);
            const float* sink = q->a_sink + l * 6; const float* wsp = q->w_sp + (size_t)l * 4 * 128 * 128; const float* bsp = q->b_sp + l * 4 * 128; const float* rb = q->rel_bias + l * 6 * 465;
            const int tid_o = vopaque(tid), lane_o = tid_o & 63;
            int btask = gwx;
#pragma unroll 1
            for (int it = vcu; it < 2304; it += G) { mixer_c_item(it, PROJ, KF, VF, MIXB, rb, q->qc_g + l * 64, lds, tid_o, wv, lane_o, btask, wsp, bsp); btask += NGW; }
#pragma unroll 1
            for (int it = vcu; it < 768; it += G) { mixer_a_item(it, PROJ, KF, VF, MIXB, sink, q->qa_g + l * 64, (const float*)(ws + WS_ROPE), lds, wv, lane_o, btask, wsp, bsp); btask += NGW; }
#pragma unroll 1
            for (; btask < 12288; btask += NGW) mixer_b_task(btask, PROJ, VF, MIXB, wsp, bsp, lane_o);
            __syncthreads();
        }
        }
        GRID_BAR();
        {
            PH_IDS; KPtr q = kopaque(kp); unsigned char* ws = q->ws; float* out = q->out;
            const float* mod_l = (const float*)(ws + WS_MOD) + (size_t)l * 5 * MODW;
            const float* xa = (l == 0) ? q->x_prompt : out; const float* xb = (l == 0) ? q->x_sample : out; const int split = (l == 0) ? MP : (1 << 30);
            pg8::Gemm g{(const bf16*)(ws + WS_MIX), (const bf16*)(ws + WS_WOUT) + (size_t)l * D * D, MTOT, D, D}; pg8::StaticOrder S; S.init(MTOT, D, G, bid);
            pg8::EpiResGateN E{xa, xb, split, out, mod_l + 2 * D, MODW, 0, (bf16*)(ws + WS_H), q->norm2_g + l * D, mod_l + 4 * D, (float*)(ws + WS_RSS) + (size_t)(2 * l + 1) * MTOT, 1};
            pg8::gemm_phase<pg8::EpiResGateN, pg8::StaticOrder, true, true>(lds, g, S, E, wv);
        }
        GRID_BAR();
#pragma unroll 1
        for (int ph = 0; ph <= NCHUNK; ++ph) {
#pragma unroll 1
            for (int step = 0; step < 2; ++step) {
            const bool swp = (sopaque((int)blockIdx.x) >> 3) & 1;
            const bool do1 = (step == 0) != swp;
            if (do1 && ph < NCHUNK) {
                const int c = ph;
                PH_IDS; KPtr q = kopaque(kp); unsigned char* ws = q->ws;
                pg8::Gemm g{(const bf16*)(ws + WS_H) + (size_t)c * CHUNK_ROWS * D, (const bf16*)(ws + WS_WFF1) + (size_t)l * DFF * D, CHUNK_ROWS, DFF, D}; pg8::StaticOrder S; S.init(CHUNK_ROWS, DFF, G, bid);
                pg8::EpiBf16N<2> E{(bf16*)(ws + WS_FFH + (size_t)(c & 1) * FFH_BYTES), DFF, (const float*)(ws + WS_RSS) + (size_t)(2 * l + 1) * MTOT, (const float*)(ws + WS_SW) + (size_t)(2 * l + 1) * 5 * 4096, 4096, c * CHUNK_ROWS, 0, 0};
                pg8::gemm_phase<pg8::EpiBf16N<2>, pg8::StaticOrder, true, true>(lds, g, S, E, wv);
            }
            if (!do1 && ph > 0) {
                const int c = ph - 1;
                PH_IDS; KPtr q = kopaque(kp); unsigned char* ws = q->ws; float* out = q->out;
                const float* mod_l = (const float*)(ws + WS_MOD) + (size_t)l * 5 * MODW;
                pg8::Gemm g{(const bf16*)(ws + WS_FFH + (size_t)(c & 1) * FFH_BYTES), (const bf16*)(ws + WS_WFF2) + (size_t)l * D * DFF, CHUNK_ROWS, D, DFF}; pg8::StaticOrder S; S.init(CHUNK_ROWS, D, G, bid);
                const float* mod_n = (const float*)(ws + WS_MOD) + (size_t)1 * 5 * MODW;
                pg8::EpiResGateN E{out, out, 1 << 30, out, mod_l + 5 * D, MODW, c * CHUNK_ROWS, (bf16*)(ws + WS_H), q->norm1_g + 1 * D, mod_n + 1 * D, (float*)(ws + WS_RSS) + (size_t)2 * MTOT, l == 0 ? 1 : 0};
                pg8::gemm_phase<pg8::EpiResGateN, pg8::StaticOrder, true, true>(lds, g, S, E, wv);
            }
            }
            if (!(l == 1 && ph == NCHUNK)) GRID_BAR();
        }
    }
#undef lane
#undef tid
}

extern "C" void kernel_launch(void* const* d_in, const int* in_sizes, int n_in, void* d_out, int out_size, void* d_ws, size_t ws_size, hipStream_t stream) {
    static int grid_blocks = 0;
    if (grid_blocks == 0) {
        if (n_in != 21 || ws_size < WS_END) { fprintf(stderr, "kernel_launch: unexpected n_in %d / ws_size %zu\n", n_in, ws_size); grid_blocks = -1; return; }
        int dev = 0, cus = 0, per_cu = 0;
        hipGetDevice(&dev);
        hipDeviceGetAttribute(&cus, hipDeviceAttributeMultiprocessorCount, dev);
        hipFuncSetAttribute((const void*)fwd_kernel, hipFuncAttributeMaxDynamicSharedMemorySize, LDS_BYTES);
        hipOccupancyMaxActiveBlocksPerMultiprocessor(&per_cu, (const void*)fwd_kernel, 512, LDS_BYTES);
        if (per_cu < 1) per_cu = 1;
        grid_blocks = cus * per_cu;
        (void)hipGetLastError();
    }
    if (grid_blocks < 0) return;
    Params p{};
    const float** pp = (const float**)&p;
    for (int i = 0; i < 21; ++i) pp[i] = (const float*)d_in[i];
    p.out = (float*)d_out; p.ws = (unsigned char*)d_ws;
    void* args[] = {&p};
    hipError_t e = hipLaunchCooperativeKernel((const void*)fwd_kernel, dim3(grid_blocks), dim3(512), args, LDS_BYTES, stream);
    if (e != hipSuccess) fprintf(stderr, "cooperative launch failed: %s (grid %d)\n", hipGetErrorString(e), grid_blocks);
}
```

```cpp
#include <hip/hip_runtime.h>
#include <hip/hip_cooperative_groups.h>
#include <cstdio>
#include <cstdint>
namespace cg = cooperative_groups;
__device__ __forceinline__ int lane_id_asm() { int l; asm volatile("v_mbcnt_lo_u32_b32 %0, -1, 0\n\tv_mbcnt_hi_u32_b32 %0, -1, %0" : "=v"(l)); return l; }
namespace pg8 {
#define PG8_LAS __attribute__((address_space(3)))
typedef unsigned short bf16_t;
typedef short bf16x8 __attribute__((ext_vector_type(8)));
typedef float f32x4 __attribute__((ext_vector_type(4)));
typedef unsigned u32x4 __attribute__((ext_vector_type(4)));
constexpr int BM = 256, BK = 64, HALF = 128, HTB = HALF * BK * 2  , STAGE_BYTES = 8 * HTB, NXCD = 8, WGM = 8;

__host__ __device__ __forceinline__ int lds_byte(int r, int c) { const int st = (r >> 4) * 2 + (c >> 5), rr = r & 15, cc = c & 31, ob = rr * 64 + cc * 2; return st * 1024 + (ob ^ (((ob >> 9) & 1) << 5)); }
__host__ __device__ __forceinline__ void stage_rc(int b, int& R, int& C) { const int st = b / 1024, sb = b % 1024, swz = sb ^ (((sb >> 9) & 1) << 5); R = (st >> 1) * 16 + swz / 64; C = (st & 1) * 32 + (swz % 64) / 2; }
__host__ __device__ __forceinline__ int perm32(int rho) { const int n = rho >> 4, i = rho & 15; return 8 * (i >> 2) + 4 * n + (i & 3); }

struct Unit { int pm, pn; };
struct Gemm { const bf16_t* A; const bf16_t* Bt; int M, N, K; };

struct StaticOrder {
    int nM, nN, nwg, G, c;
    __host__ __device__ void init(int M, int N, int G_, int c_) { nM = M / BM; nN = N / BM; nwg = nM * nN; G = G_; c = c_; }
    __host__ __device__ bool next(int i, Unit& u) const {
        const long L = (long)i * G + c; if (L >= nwg) return false;
        int wgid = (int)L; { const int q = nwg / NXCD, r = nwg % NXCD, xcd = wgid % NXCD, off = wgid / NXCD; wgid = (xcd < r ? xcd * (q + 1) : r * (q + 1) + (xcd - r) * q) + off; }
        const int nig = WGM * nN, gid = wgid / nig, fm = gid * WGM, gsz = (nM - fm) < WGM ? (nM - fm) : WGM;
        u.pm = fm + ((wgid % nig) % gsz); u.pn = (wgid % nig) / gsz; return true;
    }
    __device__ __forceinline__ void a_ready(const Unit&) const {}
    __device__ __forceinline__ void done(const Unit&) const {}
};

__device__ __forceinline__ unsigned cvt_pk_bf16(float lo, float hi) { unsigned r; asm volatile("v_cvt_pk_bf16_f32 %0, %1, %2" : "=v"(r) : "v"(lo), "v"(hi)); return r; }
template <int ACT  > struct EpiBf16 {
    static constexpr bool PERM = true, AFTER_DRAIN = false;
    bf16_t* O; int ldc;
    __device__ __forceinline__ void operator()(const f32x4 (&acc)[2][2][4][2], const Unit& u, int wr, int wc, int fr, int fq) const {
        const int row0 = u.pm * BM + wr * 64 + fr; const int col0 = u.pn * BM + wc * 32 + 8 * fq;
#pragma unroll
        for (int ai = 0; ai < 2; ++ai)
#pragma unroll
            for (int m = 0; m < 4; ++m) { bf16_t* rowp = O + (size_t)(row0 + ai * HALF + m * 16) * ldc + col0;
#pragma unroll
                for (int bj = 0; bj < 2; ++bj) { f32x4 v0 = acc[ai][bj][m][0], v1 = acc[ai][bj][m][1];
                    if (ACT == 2) {
#pragma unroll
                        for (int e = 0; e < 4; ++e) { const float a = fmaxf(v0[e], 0.f), b = fmaxf(v1[e], 0.f); v0[e] = a * a; v1[e] = b * b; } }
                    u32x4 w; w.x = cvt_pk_bf16(v0[0], v0[1]); w.y = cvt_pk_bf16(v0[2], v0[3]); w.z = cvt_pk_bf16(v1[0], v1[1]); w.w = cvt_pk_bf16(v1[2], v1[3]);
                    *(u32x4*)(rowp + bj * HALF) = w; } }
    }
};
struct EpiResGate {
    static constexpr bool PERM = false, AFTER_DRAIN = false;
    const float* baseA; const float* baseB; int split; float* out; const float* gate; int gate_stride; int row_off;
    __device__ __forceinline__ void operator()(const f32x4 (&acc)[2][2][4][2], const Unit& u, int wr, int wc, int fr, int fq) const {
        const int R0 = row_off + u.pm * BM; int b = R0 >> 13; b = b > 4 ? 4 : b;
        const float* g = gate + (size_t)b * gate_stride;
        const float* base = (R0 < split) ? baseA + (size_t)R0 * 1024 : baseB + (size_t)(R0 - split) * 1024;
        float* o = out + (size_t)R0 * 1024;
        const int col0 = u.pn * BM + wc * 32 + 4 * fq;
        f32x4 gv[2][2];
#pragma unroll
        for (int bj = 0; bj < 2; ++bj)
#pragma unroll
            for (int n = 0; n < 2; ++n) gv[bj][n] = *(const f32x4*)(g + col0 + bj * HALF + n * 16);
#pragma unroll
        for (int ai = 0; ai < 2; ++ai)
#pragma unroll
            for (int m = 0; m < 4; ++m) { const size_t off = (size_t)(ai * HALF + wr * 64 + m * 16 + fr) * 1024 + col0;
#pragma unroll
                for (int bj = 0; bj < 2; ++bj)
#pragma unroll
                    for (int n = 0; n < 2; ++n) { const f32x4 bs = *(const f32x4*)(base + off + bj * HALF + n * 16);
                        *(f32x4*)(o + off + bj * HALF + n * 16) = bs + gv[bj][n] * acc[ai][bj][m][n]; } }
    }
};

__device__ __forceinline__ float gelu_t(float x) { const float u = 0.7978845608028654f * (x + 0.044715f * x * x * x); return x * __builtin_amdgcn_rcpf(1.f + __builtin_amdgcn_exp2f(-2.8853900817779268f * u)); }
template <int ACT  > struct EpiBf16N {
    static constexpr bool PERM = true, AFTER_DRAIN = false;
    bf16_t* O; int ldc; const float* rowss; const float* bias; int ldb; int row_off; int gelu_lo, gelu_hi;
    __device__ __forceinline__ void operator()(const f32x4 (&acc)[2][2][4][2], const Unit& u, int wr, int wc, int fr, int fq) const {
        int zz = 0; asm volatile("" : "+v"(zz));
        const int R0 = row_off + u.pm * BM; int b = R0 >> 13; b = b > 4 ? 4 : b;
        const int lrow0 = u.pm * BM + wr * 64 + fr + zz; const int col0 = u.pn * BM + wc * 32 + 8 * fq + zz;
        const float* rss0_ = rowss; bf16_t* O0_ = O; const float* bias0_ = bias; asm volatile("" : "+s"(rss0_), "+s"(O0_), "+s"(bias0_));
        typedef __attribute__((address_space(1))) const float gcf; typedef __attribute__((address_space(1))) bf16_t gbf;
        gcf* rss_ = (gcf*)rss0_; gbf* O_ = (gbf*)O0_; gcf* bias_ = (gcf*)bias0_;
        gcf* bp = bias_ + (size_t)b * ldb + col0;
        f32x4 bv[2][2];
#pragma unroll
        for (int bj = 0; bj < 2; ++bj)
#pragma unroll
            for (int n = 0; n < 2; ++n) bv[bj][n] = *(const __attribute__((address_space(1))) f32x4*)(bp + bj * HALF + 4 * n);
        float rinvs[2][4];
#pragma unroll
        for (int ai = 0; ai < 2; ++ai)
#pragma unroll
            for (int m = 0; m < 4; ++m) rinvs[ai][m] = rss_[row_off + lrow0 + ai * HALF + m * 16];
#pragma unroll
        for (int ai = 0; ai < 2; ++ai)
#pragma unroll
            for (int m = 0; m < 4; ++m) { const int lr = lrow0 + ai * HALF + m * 16; gbf* rowp = O_ + (size_t)lr * ldc + col0;
                const float rinv = rsqrtf(rinvs[ai][m] * (1.f / 1024.f) + 1e-6f);
#pragma unroll
                for (int bj = 0; bj < 2; ++bj) { f32x4 v0 = acc[ai][bj][m][0] * rinv + bv[bj][0], v1 = acc[ai][bj][m][1] * rinv + bv[bj][1];
                    if (ACT == 2) {
#pragma unroll
                        for (int e = 0; e < 4; ++e) { const float a = fmaxf(v0[e], 0.f), b2 = fmaxf(v1[e], 0.f); v0[e] = a * a; v1[e] = b2 * b2; } }
                    if (ACT == 0) { const int cb = u.pn * BM + bj * HALF; if (cb >= gelu_lo && cb < gelu_hi) {
#pragma unroll
                        for (int e = 0; e < 4; ++e) { v0[e] = gelu_t(v0[e]); v1[e] = gelu_t(v1[e]); } } }
                    u32x4 w; w.x = cvt_pk_bf16(v0[0], v0[1]); w.y = cvt_pk_bf16(v0[2], v0[3]); w.z = cvt_pk_bf16(v1[0], v1[1]); w.w = cvt_pk_bf16(v1[2], v1[3]);
                    *(__attribute__((address_space(1))) u32x4*)(rowp + bj * HALF) = w; } }
    }
};
template <bool BASE_BF16  , bool OUT_BF16  > struct EpiResGateN {
    static constexpr bool PERM = true, AFTER_DRAIN = false;
    const float* baseA; const float* baseB; int split; const bf16_t* baseH; float* out; bf16_t* outH; const float* gate; int gate_stride; int row_off;
    bf16_t* XA; const float* ag; const float* ascale; float* rss; int do_next;
    __device__ __forceinline__ void operator()(const f32x4 (&acc)[2][2][4][2], const Unit& u, int wr, int wc, int fr, int fq) const {
        const int R0 = row_off + u.pm * BM; int b = R0 >> 13; b = b > 4 ? 4 : b;
        const float* g = gate + (size_t)b * gate_stride;
        const float* base = BASE_BF16 ? (const float*)nullptr : ((R0 < split) ? baseA + (size_t)R0 * 1024 : baseB + (size_t)(R0 - split) * 1024);
        const bf16_t* baseh = BASE_BF16 ? baseH + (size_t)R0 * 1024 : (const bf16_t*)nullptr;
        float* o = OUT_BF16 ? (float*)nullptr : out + (size_t)R0 * 1024; bf16_t* oh = OUT_BF16 ? outH + (size_t)R0 * 1024 : (bf16_t*)nullptr;
        bf16_t* xa_ = XA + (size_t)R0 * 1024; float* rss_ = rss + R0;
        asm volatile("" : "+s"(g), "+s"(base), "+s"(baseh), "+s"(o), "+s"(oh), "+s"(xa_), "+s"(rss_));
        typedef __attribute__((address_space(1))) const f32x4 gcv4; typedef __attribute__((address_space(1))) f32x4 gv4; typedef __attribute__((address_space(1))) const u32x4 gcu4; typedef __attribute__((address_space(1))) u32x4 gu4;
        const __attribute__((address_space(1))) float* gg_ = (const __attribute__((address_space(1))) float*)g; const __attribute__((address_space(1))) float* gbase = (const __attribute__((address_space(1))) float*)base;
        const __attribute__((address_space(1))) bf16_t* gbaseh = (const __attribute__((address_space(1))) bf16_t*)baseh;
        __attribute__((address_space(1))) float* go = (__attribute__((address_space(1))) float*)o; __attribute__((address_space(1))) bf16_t* goh = (__attribute__((address_space(1))) bf16_t*)oh;
        __attribute__((address_space(1))) bf16_t* gxa = (__attribute__((address_space(1))) bf16_t*)xa_; __attribute__((address_space(1))) float* grss = (__attribute__((address_space(1))) float*)rss_;
        const __attribute__((address_space(1))) float* gag = (const __attribute__((address_space(1))) float*)ag; const __attribute__((address_space(1))) float* gasc = (const __attribute__((address_space(1))) float*)ascale;
        int zz = 0; asm volatile("" : "+v"(zz));
        const int col0 = u.pn * BM + wc * 32 + 8 * fq + zz;
        f32x4 gv[2][2], av[2][2];
#pragma unroll
        for (int bj = 0; bj < 2; ++bj)
#pragma unroll
            for (int n = 0; n < 2; ++n) { gv[bj][n] = *(gcv4*)(gg_ + col0 + bj * HALF + n * 4);
                if (do_next) av[bj][n] = *(gcv4*)(gag + col0 + bj * HALF + n * 4) * (*(gcv4*)(gasc + (size_t)b * gate_stride + col0 + bj * HALF + n * 4) + 1.f);
                else av[bj][n] = (f32x4){0.f, 0.f, 0.f, 0.f}; }
        f32x4 bs[2][2][2]; u32x4 bsh[2][2];
        const unsigned rc0 = (unsigned)(wr * 64 + fr + zz) * 1024u + (unsigned)col0;
#define RG_LOAD(rg, buf) do { const unsigned off_ = rc0 + (unsigned)(((rg) >> 2) * HALF + ((rg) & 3) * 16) * 1024u; \
        if (BASE_BF16) { _Pragma("unroll") for (int bj = 0; bj < 2; ++bj) bsh[buf][bj] = *(gcu4*)(gbaseh + off_ + bj * HALF); } \
        else { _Pragma("unroll") for (int bj = 0; bj < 2; ++bj) _Pragma("unroll") for (int n = 0; n < 2; ++n) bs[buf][bj][n] = *(gcv4*)(gbase + off_ + bj * HALF + n * 4); } } while (0)
        RG_LOAD(0, 0);
#pragma unroll
        for (int rg = 0; rg < 8; ++rg) {
            const int ai = rg >> 2, m = rg & 3;
            if (rg + 1 < 8) RG_LOAD(rg + 1, (rg + 1) & 1);
            __builtin_amdgcn_sched_barrier(0);
            const int r = ai * HALF + wr * 64 + m * 16 + fr; const unsigned off = rc0 + (unsigned)(ai * HALF + m * 16) * 1024u; float ssq = 0.f;
#pragma unroll
            for (int bj = 0; bj < 2; ++bj) { f32x4 x[2];
                if (BASE_BF16) { const u32x4 h = bsh[rg & 1][bj];
                    const f32x4 b0 = {__uint_as_float(h.x << 16), __uint_as_float(h.x & 0xffff0000u), __uint_as_float(h.y << 16), __uint_as_float(h.y & 0xffff0000u)};
                    const f32x4 b1 = {__uint_as_float(h.z << 16), __uint_as_float(h.z & 0xffff0000u), __uint_as_float(h.w << 16), __uint_as_float(h.w & 0xffff0000u)};
                    x[0] = b0 + gv[bj][0] * acc[ai][bj][m][0]; x[1] = b1 + gv[bj][1] * acc[ai][bj][m][1];
                } else {
#pragma unroll
                    for (int n = 0; n < 2; ++n) x[n] = bs[rg & 1][bj][n] + gv[bj][n] * acc[ai][bj][m][n];
                }
                if (OUT_BF16) { u32x4 w; w.x = cvt_pk_bf16(x[0][0], x[0][1]); w.y = cvt_pk_bf16(x[0][2], x[0][3]); w.z = cvt_pk_bf16(x[1][0], x[1][1]); w.w = cvt_pk_bf16(x[1][2], x[1][3]);
                    *(gu4*)(goh + off + bj * HALF) = w;
                } else {
#pragma unroll
                    for (int n = 0; n < 2; ++n) *(gv4*)(go + off + bj * HALF + n * 4) = x[n];
                }
                if (do_next) { ssq += ((x[0][0] * x[0][0] + x[0][1] * x[0][1]) + (x[0][2] * x[0][2] + x[0][3] * x[0][3])) + ((x[1][0] * x[1][0] + x[1][1] * x[1][1]) + (x[1][2] * x[1][2] + x[1][3] * x[1][3]));
                    const f32x4 y0 = x[0] * av[bj][0], y1 = x[1] * av[bj][1];
                    u32x4 w; w.x = cvt_pk_bf16(y0[0], y0[1]); w.y = cvt_pk_bf16(y0[2], y0[3]); w.z = cvt_pk_bf16(y1[0], y1[1]); w.w = cvt_pk_bf16(y1[2], y1[3]);
                    *(gu4*)(gxa + off + bj * HALF) = w; } }
            if (do_next) { ssq += __shfl_xor(ssq, 16); ssq += __shfl_xor(ssq, 32);
                if (fq == 0) __hip_atomic_fetch_add((float*)(grss + r), ssq, __ATOMIC_RELAXED, __HIP_MEMORY_SCOPE_AGENT); }
            __builtin_amdgcn_sched_barrier(0);
        }
#undef RG_LOAD
    }
};
template <class Epi, class Sched, bool ALIGN_EPI = false, bool SP2 = false>
__device__ __forceinline__ void gemm_phase(PG8_LAS unsigned char* lds, const Gemm g, const Sched& S, const Epi& E, int wave_in) {
    int tid_ = wave_in * 64 + ::lane_id_asm();
    const int tid = tid_, wid = __builtin_amdgcn_readfirstlane(tid >> 6), lane = tid & 63, wr = wid >> 2, wc = wid & 3, fr = lane & 15, fq = lane >> 4;
    const int K = g.K, nt = K / BK;
    unsigned voffA[2], voffB[2];
#pragma unroll
    for (int i = 0; i < 2; ++i) { int R, C; stage_rc(tid * 16 + i * 8192, R, C); const int Rb = Epi::PERM ? ((R & ~31) + perm32(R & 31)) : R;
        voffA[i] = (unsigned)(R * K + C) * 2u; voffB[i] = (unsigned)(Rb * K + C) * 2u; }
    const size_t kstep = (size_t)(BK * 2);
    const size_t hstep = (size_t)HALF * K * 2;
    const size_t tstep = 2 * hstep;
    const unsigned ldsw = (unsigned)wid * 1024u;
    const int aoff = lds_byte(wr * 64 + fr, fq * 8), boff = lds_byte(wc * 32 + fr, fq * 8);
#define PG8_SA(b, h) (((b) * 2 + (h)) * HTB)
#define PG8_SB(b, h) ((4 + (b) * 2 + (h)) * HTB)
#define PG8_STAGE(bufoff, gbase, voff) do { _Pragma("unroll") for (int _i = 0; _i < 2; ++_i) \
        __builtin_amdgcn_global_load_lds((const unsigned*)((const char*)(gbase) + (voff)[_i]), (PG8_LAS unsigned*)(lds + (bufoff) + ldsw + _i * 8192), 16, 0, 0); } while (0)
#define PG8_LDA(dst, b, h) do { _Pragma("unroll") for (int m = 0; m < 4; ++m) _Pragma("unroll") for (int k = 0; k < 2; ++k) dst[m][k] = *(const PG8_LAS bf16x8*)(lds + PG8_SA(b, h) + aoff + m * 2048 + k * 1024); } while (0)
#define PG8_LDB(dst, b, h) do { _Pragma("unroll") for (int n = 0; n < 2; ++n) _Pragma("unroll") for (int k = 0; k < 2; ++k) dst[n][k] = *(const PG8_LAS bf16x8*)(lds + PG8_SB(b, h) + boff + n * 2048 + k * 1024); } while (0)
#define PG8_MMA(ai, bj, At, Bt) do { __builtin_amdgcn_s_setprio(1); _Pragma("unroll") for (int m = 0; m < 4; ++m) _Pragma("unroll") for (int n = 0; n < 2; ++n) _Pragma("unroll") for (int k = 0; k < 2; ++k) \
        acc[ai][bj][m][n] = __builtin_amdgcn_mfma_f32_16x16x32_bf16(Bt[n][k], At[m][k], acc[ai][bj][m][n], 0, 0, 0); __builtin_amdgcn_s_setprio(0); } while (0)
#define PG8_WAIT_V(n) asm volatile("s_waitcnt vmcnt(" #n ")" ::: "memory")
#define PG8_WAIT_L(n) asm volatile("s_waitcnt lgkmcnt(" #n ")" ::: "memory")
#define PG8_BAR __builtin_amdgcn_s_barrier()
#define PG8_SCHED __builtin_amdgcn_sched_barrier(0)
    Unit cur, nxt; int ui = 0;
    if (!S.next(0, cur)) return;
    f32x4 acc[2][2][4][2];
#pragma unroll
    for (int a = 0; a < 2; ++a)
#pragma unroll
        for (int b = 0; b < 2; ++b)
#pragma unroll
            for (int m = 0; m < 4; ++m)
#pragma unroll
                for (int n = 0; n < 2; ++n) acc[a][b][m][n] = (f32x4){0.f, 0.f, 0.f, 0.f};
    bf16x8 At[4][2], B0[2][2], B1[2][2];
    const char* cA = (const char*)g.A + (size_t)cur.pm * tstep; const char* cB = (const char*)g.Bt + (size_t)cur.pn * tstep;
    S.a_ready(cur);
    if constexpr (SP2) {
        PG8_STAGE(PG8_SB(0, 0), cB, voffB); PG8_STAGE(PG8_SB(0, 1), cB + hstep, voffB); PG8_STAGE(PG8_SA(0, 0), cA, voffA); PG8_STAGE(PG8_SA(0, 1), cA + hstep, voffA);
        if (wr == 1) PG8_BAR;
        PG8_WAIT_V(2); PG8_BAR;
        PG8_STAGE(PG8_SB(1, 0), cB + kstep, voffB); PG8_STAGE(PG8_SA(1, 0), cA + kstep, voffA); PG8_STAGE(PG8_SB(1, 1), cB + hstep + kstep, voffB);
        PG8_WAIT_V(6); PG8_BAR;
    } else {
        PG8_STAGE(PG8_SB(0, 0), cB, voffB); PG8_STAGE(PG8_SA(0, 0), cA, voffA); PG8_STAGE(PG8_SB(0, 1), cB + hstep, voffB); PG8_STAGE(PG8_SA(0, 1), cA + hstep, voffA);
        if (wr == 1) PG8_BAR;
        PG8_WAIT_V(4); PG8_BAR;
        PG8_STAGE(PG8_SB(1, 0), cB + kstep, voffB); PG8_STAGE(PG8_SA(1, 0), cA + kstep, voffA); PG8_STAGE(PG8_SB(1, 1), cB + hstep + kstep, voffB);
        PG8_WAIT_V(6); PG8_BAR;
    }
    for (;;) {
        const bool has_next = S.next(ui + 1, nxt);
        const char* nA = has_next ? (const char*)g.A + (size_t)nxt.pm * tstep : cA; const char* nB = has_next ? (const char*)g.Bt + (size_t)nxt.pn * tstep : cB;
        for (int t = 0; t < nt; t += 2) {
            const bool last = (t == nt - 2);
            const char* a1 = cA + (size_t)(t + 1) * kstep;
            const char* a2 = last ? nA : cA + (size_t)(t + 2) * kstep; const char* b2 = last ? nB : cB + (size_t)(t + 2) * kstep;
            const char* a3 = a2 + kstep; const char* b3 = b2 + kstep;
            if (last && has_next) S.a_ready(nxt);
            if constexpr (SP2) {
            PG8_LDB(B0, 0, 0); PG8_LDB(B1, 0, 1); PG8_SCHED; PG8_LDA(At, 0, 0); PG8_STAGE(PG8_SA(1, 1), a1 + hstep, voffA);
            PG8_WAIT_V(8); PG8_WAIT_L(0); PG8_BAR; PG8_MMA(0, 0, At, B0); PG8_MMA(0, 1, At, B1); PG8_BAR; PG8_SCHED;
            PG8_LDA(At, 0, 1); PG8_STAGE(PG8_SB(0, 0), b2, voffB); PG8_STAGE(PG8_SB(0, 1), b2 + hstep, voffB); PG8_STAGE(PG8_SA(0, 0), a2, voffA);
            PG8_WAIT_V(8); PG8_WAIT_L(0); PG8_BAR; PG8_MMA(1, 0, At, B0); PG8_MMA(1, 1, At, B1); PG8_BAR; PG8_SCHED;
            PG8_LDB(B0, 1, 0); PG8_LDB(B1, 1, 1); PG8_SCHED; PG8_LDA(At, 1, 0); PG8_STAGE(PG8_SA(0, 1), a2 + hstep, voffA);
            PG8_WAIT_V(8); PG8_WAIT_L(0); PG8_BAR; PG8_MMA(0, 0, At, B0); PG8_MMA(0, 1, At, B1); PG8_BAR; PG8_SCHED;
            PG8_LDA(At, 1, 1); PG8_STAGE(PG8_SB(1, 0), b3, voffB); PG8_STAGE(PG8_SB(1, 1), b3 + hstep, voffB); PG8_STAGE(PG8_SA(1, 0), a3, voffA);
            PG8_WAIT_V(8); PG8_WAIT_L(0); PG8_BAR; PG8_MMA(1, 0, At, B0); PG8_MMA(1, 1, At, B1); PG8_BAR; PG8_SCHED;
            } else {
            PG8_LDB(B0, 0, 0); PG8_SCHED; PG8_LDA(At, 0, 0); PG8_STAGE(PG8_SA(1, 1), a1 + hstep, voffA);
            PG8_WAIT_L(8); PG8_BAR; PG8_WAIT_L(0); PG8_MMA(0, 0, At, B0); PG8_BAR; PG8_SCHED;
            PG8_LDB(B1, 0, 1); PG8_STAGE(PG8_SB(0, 0), b2, voffB);
            PG8_BAR; PG8_WAIT_L(0); PG8_MMA(0, 1, At, B1); PG8_BAR;
            PG8_LDA(At, 0, 1); PG8_STAGE(PG8_SA(0, 0), a2, voffA);
            PG8_BAR; PG8_WAIT_L(0); PG8_MMA(1, 0, At, B0); PG8_BAR; PG8_SCHED;
            PG8_STAGE(PG8_SB(0, 1), b2 + hstep, voffB);
            PG8_WAIT_V(6); PG8_BAR; PG8_MMA(1, 1, At, B1); PG8_BAR;
            PG8_LDB(B0, 1, 0); PG8_SCHED; PG8_LDA(At, 1, 0); PG8_STAGE(PG8_SA(0, 1), a2 + hstep, voffA);
            PG8_WAIT_L(8); PG8_BAR; PG8_WAIT_L(0); PG8_MMA(0, 0, At, B0); PG8_BAR; PG8_SCHED;
            PG8_LDB(B1, 1, 1); PG8_STAGE(PG8_SB(1, 0), b3, voffB);
            PG8_BAR; PG8_WAIT_L(0); PG8_MMA(0, 1, At, B1); PG8_BAR;
            PG8_LDA(At, 1, 1); PG8_STAGE(PG8_SA(1, 0), a3, voffA);
            PG8_BAR; PG8_WAIT_L(0); PG8_MMA(1, 0, At, B0); PG8_BAR; PG8_SCHED;
            PG8_STAGE(PG8_SB(1, 1), b3 + hstep, voffB);
            PG8_WAIT_V(6); PG8_BAR; PG8_MMA(1, 1, At, B1); PG8_BAR;
            }
        }
        if constexpr (ALIGN_EPI) { if (wr == 0) PG8_BAR; }
        if constexpr (!Epi::AFTER_DRAIN) { E(acc, cur, wr, wc, fr, fq); S.done(cur); }
        if (!has_next) break;
#pragma unroll
        for (int a = 0; a < 2; ++a)
#pragma unroll
            for (int b = 0; b < 2; ++b)
#pragma unroll
                for (int m = 0; m < 4; ++m)
#pragma unroll
                    for (int n = 0; n < 2; ++n) acc[a][b][m][n] = (f32x4){0.f, 0.f, 0.f, 0.f};
        cur = nxt; cA = nA; cB = nB; ++ui;
        if constexpr (ALIGN_EPI) { if (wr == 1) PG8_BAR; }
    }
    PG8_WAIT_V(0);
    if constexpr (!ALIGN_EPI) { if (wr == 0) PG8_BAR; }
    PG8_BAR;
    if constexpr (Epi::AFTER_DRAIN) { E.fused(acc, cur, wr, wc, fr, fq, lds, wid, lane); S.done(cur); }
#undef PG8_SA
#undef PG8_SB
#undef PG8_STAGE
#undef PG8_LDA
#undef PG8_LDB
#undef PG8_MMA
#undef PG8_WAIT_V
#undef PG8_WAIT_L
#undef PG8_BAR
#undef PG8_SCHED
}
}

#define LAS __attribute__((address_space(3)))
typedef unsigned short bf16;
typedef short bf16x8 __attribute__((ext_vector_type(8)));
typedef float f32x4 __attribute__((ext_vector_type(4)));
typedef unsigned u32x4v __attribute__((ext_vector_type(4)));
typedef unsigned u32x2v __attribute__((ext_vector_type(2)));

constexpr int D = 1024, DIN = 2304, DFF = 4096, MTOT = 49152, MP = 32768, MODW = 6144;
constexpr int CHUNK_ROWS = 16384, NCHUNK = 3;
constexpr float EPS = 1e-6f, LOG2E = 1.4426950408889634f, QSCALE = 0.125f * 1.4426950408889634f;
constexpr int LDS_BAR_OFF = 153344;
constexpr int LDS_BYTES = 153600;
constexpr size_t WS_BAR = 0;
constexpr size_t MiB = 1u << 20;
constexpr size_t WS_WIN = 1 * MiB, WS_WOUT = 10 * MiB, WS_WFF1 = 14 * MiB, WS_WFF2 = 30 * MiB, WS_MOD = 46 * MiB, WS_ROPE = 47 * MiB;
constexpr size_t WS_H = 48 * MiB, WS_PROJ = 144 * MiB, WS_MIX = 360 * MiB;
constexpr size_t WS_X1B = 144 * MiB  , WS_FFH = 240 * MiB  ;
constexpr size_t WS_RSS = 46 * MiB + 256 * 1024  , WS_SW = 64 * 1024  ;
constexpr size_t FFH_BYTES = 128 * MiB;
constexpr size_t WS_VF = WS_H  , WS_KF = 456 * MiB, WS_END = 504 * MiB;

struct Params {
    const float *x_prompt, *x_sample, *c_prompt, *c_sample, *norm1_g, *norm2_g, *w_ada, *b_ada, *w_in, *qa_g, *ka_g, *a_sink, *bv_g, *w_sp, *b_sp,
        *qc_g, *kc_g, *rel_bias, *w_out, *w_ff1, *w_ff2;
    float* out; unsigned char* ws;
};

__device__ __forceinline__ float bf_lo(unsigned w) { return __uint_as_float(w << 16); }
__device__ __forceinline__ float bf_hi(unsigned w) { return __uint_as_float(w & 0xffff0000u); }
__device__ __forceinline__ unsigned pack2(float lo, float hi) { return pg8::cvt_pk_bf16(lo, hi); }
__device__ __forceinline__ float wave_sum(float v) {
#pragma unroll
    for (int o = 1; o < 64; o <<= 1) v += __shfl_xor(v, o);
    return v;
}
__device__ __forceinline__ float gelu_tanh(float x) {
    const float u = 0.7978845608028654f * (x + 0.044715f * x * x * x);
    return x * __builtin_amdgcn_rcpf(1.f + __builtin_amdgcn_exp2f(-2.f * LOG2E * u));
}
template <int CTRL> __device__ __forceinline__ float dpp_f(float v) { return __builtin_bit_cast(float, __builtin_amdgcn_update_dpp(0, __builtin_bit_cast(int, v), CTRL, 0xf, 0xf, false)); }
__device__ __forceinline__ float sum16(float s) {
    s += dpp_f<0xB1>(s); s += dpp_f<0x4E>(s); s += dpp_f<0x141>(s); s += dpp_f<0x140>(s); return s;
}
__device__ __forceinline__ f32x4 mfma16(bf16x8 a, bf16x8 b, f32x4 c) { return __builtin_amdgcn_mfma_f32_16x16x32_bf16(a, b, c, 0, 0, 0); }

__device__ __forceinline__ void transpose_item(const float* W, int K, int N, bf16* WT, LAS float* scr, int item, int lane) {
    const int nblk = N / 32, kb = item / nblk, nb = item % nblk, k0 = 64 * kb, n0 = 32 * nb;
#pragma unroll 8
    for (int i = 0; i < 32; ++i) { const int kk = 2 * i + (lane >> 5); scr[kk * 33 + (lane & 31)] = W[(size_t)(k0 + kk) * N + n0 + (lane & 31)]; }
    asm volatile("s_waitcnt lgkmcnt(0)" ::: "memory");
    const int c = lane & 7;
#pragma unroll
    for (int j = 0; j < 4; ++j) { const int n = (lane >> 3) + 8 * j; const LAS float* s = scr + (8 * c) * 33 + n;
        u32x4v o; o.x = pack2(s[0 * 33], s[1 * 33]); o.y = pack2(s[2 * 33], s[3 * 33]); o.z = pack2(s[4 * 33], s[5 * 33]); o.w = pack2(s[6 * 33], s[7 * 33]);
        *(u32x4v*)(WT + (size_t)(n0 + n) * K + k0 + 8 * c) = o; }
    asm volatile("s_waitcnt lgkmcnt(0)" ::: "memory");
}

__device__ __forceinline__ int vopaque(int v) { asm volatile("" : "+v"(v)); return v; }
__device__ __forceinline__ int sopaque(int v) { asm volatile("" : "+s"(v)); return v; }
typedef const __attribute__((address_space(4))) Params* KPtr;
__device__ __forceinline__ KPtr kopaque(KPtr q) { asm volatile("" : "+s"(q)); return q; }
template <int SEL> __device__ __forceinline__ void transposes(KPtr kp, LAS unsigned char* lds, int gw, int NGW, int wave, int lane) {
    KPtr p = kopaque(kp); unsigned char* ws = p->ws;
    LAS float* scr = (LAS float*)(lds + wave * 16384);
    constexpr int I_IN = 16 * 72, I_OUT = 16 * 32, I_F1 = 16 * 128, I_F2 = 64 * 32;
    if (SEL == 0) { for (int it = gw; it < 2 * I_IN; it += NGW) { const int l = it / I_IN, r = it % I_IN;
        transpose_item(p->w_in + (size_t)l * D * DIN, D, DIN, (bf16*)(ws + WS_WIN) + (size_t)l * DIN * D, scr, r, lane); } }
    if (SEL == 1) { for (int it = gw; it < 2 * I_OUT; it += NGW) { const int l = it / I_OUT, r = it % I_OUT;
        transpose_item(p->w_out + (size_t)l * D * D, D, D, (bf16*)(ws + WS_WOUT) + (size_t)l * D * D, scr, r, lane); } }
    if (SEL == 2) { for (int it = gw; it < 2 * (I_F1 + I_F2); it += NGW) { const int l = it / (I_F1 + I_F2), r = it % (I_F1 + I_F2);
        if (r < I_F1) transpose_item(p->w_ff1 + (size_t)l * D * DFF, D, DFF, (bf16*)(ws + WS_WFF1) + (size_t)l * DFF * D, scr, r, lane);
        else transpose_item(p->w_ff2 + (size_t)l * DFF * D, DFF, D, (bf16*)(ws + WS_WFF2) + (size_t)l * D * DFF, scr, r - I_F1, lane); } }
}
__device__ __forceinline__ void phase0a(KPtr kp, LAS unsigned char* lds, int tid, int wave, int lane) {
    KPtr p = kopaque(kp); unsigned char* ws = p->ws;
    {
        float* z0 = (float*)(ws + WS_MOD); float* z1 = (float*)(ws + WS_SW);
        for (int i = blockIdx.x * 512 + tid; i < (1 << 18); i += gridDim.x * 512) z0[i] = 0.f;
        for (int i = blockIdx.x * 512 + tid; i < 4 * 5 * 4096; i += gridDim.x * 512) z1[i] = 0.f;
    }
    {
        float* rc = (float*)(ws + WS_ROPE); float* rs = rc + 16384 * 8;
        for (int i = blockIdx.x * 512 + tid; i < 16384 * 8; i += gridDim.x * 512) {
            const int pos = i >> 3, f = i & 7;
            const float inv = f == 0 ? 1.0f : f == 1 ? 0.19392274474868576f : f == 2 ? 0.03760603093086393f : f == 3 ? 0.007292664737217109f :
                              f == 4 ? 0.001414213562373095f : f == 5 ? 0.0002742481756762073f : f == 6 ? 5.318295896944988e-05f : 1.031338537721246e-05f;
            const float ang = (float)pos * inv;
            double rev = (double)ang * 0.15915494309189535; rev -= __builtin_floor(rev);
            rc[i] = __builtin_amdgcn_cosf((float)rev); rs[i] = __builtin_amdgcn_sinf((float)rev);
        }
    }
    transposes<0>(kp, lds, blockIdx.x * 8 + wave, gridDim.x * 8, wave, lane);
}
__device__ __forceinline__ void phase0b(KPtr kp, LAS unsigned char* lds, int gw, int NGW, int wave, int lane) {
    KPtr p = kopaque(kp); unsigned char* ws = p->ws;
    float* mod = (float*)(ws + WS_MOD);
    LAS float* sl = (LAS float*)(lds + wave * 16384);
    for (int item = gw; item < 1536; item += NGW) {
        const int ks = item & 7, r = item >> 3, l = r / 96, col0 = (r % 96) * 64;
        for (int i = lane; i < 640; i += 64) { const int b = i >> 7, k = ks * 128 + (i & 127); const float c = (b < 4) ? p->c_prompt[b * 1024 + k] : p->c_sample[k];
            sl[i] = c * __builtin_amdgcn_rcpf(1.f + __expf(-c)); }
        asm volatile("s_waitcnt lgkmcnt(0)" ::: "memory");
        const float* W = p->w_ada + (size_t)l * 1024 * MODW + (size_t)ks * 128 * MODW + col0 + lane;
        float a0 = 0.f, a1 = 0.f, a2 = 0.f, a3 = 0.f, a4 = 0.f;
#pragma unroll 16
        for (int kk = 0; kk < 128; ++kk) { const float w = W[(size_t)kk * MODW];
            a0 += sl[kk] * w; a1 += sl[128 + kk] * w; a2 += sl[256 + kk] * w; a3 += sl[384 + kk] * w; a4 += sl[512 + kk] * w; }
        if (ks == 0) { const float bb = p->b_ada[l * MODW + col0 + lane]; a0 += bb; a1 += bb; a2 += bb; a3 += bb; a4 += bb; }
        float* m = mod + (size_t)(l * 5) * MODW + col0 + lane;
        __hip_atomic_fetch_add(m, a0, __ATOMIC_RELAXED, __HIP_MEMORY_SCOPE_AGENT); __hip_atomic_fetch_add(m + MODW, a1, __ATOMIC_RELAXED, __HIP_MEMORY_SCOPE_AGENT);
        __hip_atomic_fetch_add(m + 2 * MODW, a2, __ATOMIC_RELAXED, __HIP_MEMORY_SCOPE_AGENT); __hip_atomic_fetch_add(m + 3 * MODW, a3, __ATOMIC_RELAXED, __HIP_MEMORY_SCOPE_AGENT);
        __hip_atomic_fetch_add(m + 4 * MODW, a4, __ATOMIC_RELAXED, __HIP_MEMORY_SCOPE_AGENT);
        asm volatile("s_waitcnt lgkmcnt(0)" ::: "memory");
    }
    transposes<1>(kp, lds, gw, NGW, wave, lane);
}

__device__ __forceinline__ void xa_phase(const float* xa, const float* xb, int split, const float* g, const float* scale  , bf16* H, float* rss, int gw, int NGW, int lane_in) {
    const int lane = vopaque(lane_in);
    f32x4 vn[4];
    if (gw < MTOT) { const float* xrow = (gw < split) ? xa + (size_t)gw * D : xb + (size_t)(gw - split) * D; const f32x4* xr = (const f32x4*)xrow + lane;
#pragma unroll
        for (int j = 0; j < 4; ++j) vn[j] = xr[64 * j]; }
    for (int m = gw; m < MTOT; m += NGW) {
        int b = m >> 13; b = b > 4 ? 4 : b;
        f32x4 v[4]; float ss = 0.f;
#pragma unroll
        for (int j = 0; j < 4; ++j) { v[j] = vn[j]; ss += (v[j].x * v[j].x + v[j].y * v[j].y) + (v[j].z * v[j].z + v[j].w * v[j].w); }
        const int mn = m + NGW;
        if (mn < MTOT) { const float* xrow = (mn < split) ? xa + (size_t)mn * D : xb + (size_t)(mn - split) * D; const f32x4* xr = (const f32x4*)xrow + lane;
#pragma unroll
            for (int j = 0; j < 4; ++j) vn[j] = xr[64 * j]; }
        f32x4 gg[4], sc[4];
#pragma unroll
        for (int j = 0; j < 4; ++j) { const int col = 256 * j + 4 * lane; gg[j] = *(const f32x4*)(g + col); sc[j] = *(const f32x4*)(scale + (size_t)b * MODW + col); }
        __builtin_amdgcn_sched_barrier(0);
        ss = wave_sum(ss);
        if (lane == 0) rss[m] = ss;
        u32x2v* o = (u32x2v*)(H + (size_t)m * D) + lane;
#pragma unroll
        for (int j = 0; j < 4; ++j) {
            const f32x4 y = v[j] * gg[j] * (sc[j] + 1.f);
            u32x2v w; w.x = pack2(y.x, y.y); w.y = pack2(y.z, y.w); o[64 * j] = w; }
    }
}
__device__ __forceinline__ void sw_phase(const float* mod, const float* w_in, const float* w_ff1, float* sW, LAS unsigned char* lds, int gw, int NGW, int wave, int lane) {
    LAS float* sl = (LAS float*)(lds + wave * 16384);
    for (int item = gw; item < 1600; item += NGW) {
        const int ks = item & 7, r0 = item >> 3, l = r0 / 100, r = r0 % 100, which = r < 36 ? 0 : 1, cc = which ? r - 36 : r, N = which ? DFF : DIN, col0 = cc * 64;
        const float* sh = mod + (size_t)l * 5 * MODW + (which ? 3 * D : 0) + ks * 128;
        for (int i = lane; i < 640; i += 64) sl[i] = sh[(size_t)(i >> 7) * MODW + (i & 127)];
        asm volatile("s_waitcnt lgkmcnt(0)" ::: "memory");
        const float* W = (which ? w_ff1 + (size_t)l * D * DFF : w_in + (size_t)l * D * DIN) + (size_t)ks * 128 * N + col0 + lane;
        float a0 = 0.f, a1 = 0.f, a2 = 0.f, a3 = 0.f, a4 = 0.f;
#pragma unroll 16
        for (int kk = 0; kk < 128; ++kk) { const float w = W[(size_t)kk * N];
            a0 += sl[kk] * w; a1 += sl[128 + kk] * w; a2 += sl[256 + kk] * w; a3 += sl[384 + kk] * w; a4 += sl[512 + kk] * w; }
        float* o = sW + ((size_t)(l * 2 + which) * 5) * 4096 + col0 + lane;
        __hip_atomic_fetch_add(o, a0, __ATOMIC_RELAXED, __HIP_MEMORY_SCOPE_AGENT); __hip_atomic_fetch_add(o + 4096, a1, __ATOMIC_RELAXED, __HIP_MEMORY_SCOPE_AGENT);
        __hip_atomic_fetch_add(o + 2 * 4096, a2, __ATOMIC_RELAXED, __HIP_MEMORY_SCOPE_AGENT); __hip_atomic_fetch_add(o + 3 * 4096, a3, __ATOMIC_RELAXED, __HIP_MEMORY_SCOPE_AGENT);
        __hip_atomic_fetch_add(o + 4 * 4096, a4, __ATOMIC_RELAXED, __HIP_MEMORY_SCOPE_AGENT);
        asm volatile("s_waitcnt lgkmcnt(0)" ::: "memory");
    }
}

__device__ __forceinline__ int prep_unit(int gidx, int grp) { return gidx == 0 ? 6 + grp : gidx == 1 ? 14 + grp : 24 + (gidx - 2) * 4 + grp; }
__device__ __forceinline__ void prep_task(int task, const bf16* P, bf16* KF, bf16* VF, const float* ka_g, const float* bv_g, const float* kc_g,
                                          const float* ropeC, const float* ropeS, LAS unsigned char* wlds, int lane) {
    const int tb = task / 5, gidx = task % 5;
    const int sub = lane & 15, grp = lane >> 4;
    const int u = prep_unit(gidx, grp);
    const bool isk = (u >= 6 && u < 8) || (u >= 24 && u < 30), isbv = (u >= 14 && u < 18);
    const bool isv = !isk;
    const bf16* base = P + (size_t)tb * 16 * DIN + u * 64 + 4 * sub;
    const float* gp = (u < 8) ? ka_g : kc_g;
    const f32x4 gg = *(const f32x4*)(gp + 4 * sub);
    f32x4 g2 = {1.f, 1.f, 1.f, 1.f};
    if (isbv) g2 = *(const f32x4*)(bv_g + (u - 14) * 64 + 4 * sub);
    const int m0 = tb * 16, pos0 = (m0 < MP) ? (m0 & 8191) : (m0 - MP);
    LAS unsigned char* reg = wlds + grp * 2048;
    const int c = sub >> 1;
    u32x2v rawn[4];
#pragma unroll
    for (int j = 0; j < 4; ++j) rawn[j] = *(const u32x2v*)(base + (size_t)j * DIN);
#pragma unroll 1
    for (int tq4 = 0; tq4 < 4; ++tq4) {
        u32x2v raw[4];
#pragma unroll
        for (int j = 0; j < 4; ++j) raw[j] = rawn[j];
        if (tq4 < 3) {
#pragma unroll
            for (int j = 0; j < 4; ++j) rawn[j] = *(const u32x2v*)(base + (size_t)(4 * tq4 + 4 + j) * DIN);
        }
        float vk[4][4];
#pragma unroll
        for (int j = 0; j < 4; ++j) {
            const int tk = 4 * tq4 + j;
            float x[4] = {bf_lo(raw[j].x), bf_hi(raw[j].x), bf_lo(raw[j].y), bf_hi(raw[j].y)};
            float o[4];
            if (gidx == 1) {
                float sq = sum16((x[0] * x[0] + x[1] * x[1]) + (x[2] * x[2] + x[3] * x[3])); sq += __shfl_xor(sq, 16); sq += __shfl_xor(sq, 32);
                const float r2 = __builtin_amdgcn_rsqf(sq * (1.f / 256.f) + EPS);
                o[0] = x[0] * r2 * g2.x; o[1] = x[1] * r2 * g2.y; o[2] = x[2] * r2 * g2.z; o[3] = x[3] * r2 * g2.w;
            } else if (gidx == 4) {
#pragma unroll
                for (int i = 0; i < 4; ++i) o[i] = x[i];
            } else {
                float ss = sum16((x[0] * x[0] + x[1] * x[1]) + (x[2] * x[2] + x[3] * x[3]));
                const float rinv = __builtin_amdgcn_rsqf(ss * (1.f / 64.f) + EPS);
                float y[4] = {x[0] * rinv * gg.x, x[1] * rinv * gg.y, x[2] * rinv * gg.z, x[3] * rinv * gg.w};
                if (gidx == 0) {
                    float yp[4];
#pragma unroll
                    for (int i = 0; i < 4; ++i) yp[i] = dpp_f<0x4E>(y[i]);
                    if (sub < 4) {
                        const f32x4 c4 = *(const f32x4*)(ropeC + (pos0 + tk) * 8 + 4 * (sub & 1)), s4 = *(const f32x4*)(ropeS + (pos0 + tk) * 8 + 4 * (sub & 1));
                        const float sg = (sub < 2) ? -1.f : 1.f;
                        y[0] = y[0] * c4.x + sg * yp[0] * s4.x; y[1] = y[1] * c4.y + sg * yp[1] * s4.y; y[2] = y[2] * c4.z + sg * yp[2] * s4.z; y[3] = y[3] * c4.w + sg * yp[3] * s4.w;
                    }
                }
#pragma unroll
                for (int i = 0; i < 4; ++i) o[i] = isk ? y[i] : x[i];
            }
            if (isk) { u32x2v w; w.x = pack2(o[0], o[1]); w.y = pack2(o[2], o[3]);
                *(LAS u32x2v*)(reg + (c * 16 + (tk ^ c)) * 16 + (sub & 1) * 8) = w; }
#pragma unroll
            for (int i = 0; i < 4; ++i) vk[j][i] = o[i];
        }
        if (isv) {
#pragma unroll
            for (int i = 0; i < 4; ++i) { const int d = 4 * sub + i;
                u32x2v w; w.x = pack2(vk[0][i], vk[1][i]); w.y = pack2(vk[2][i], vk[3][i]);
                *(LAS u32x2v*)(reg + (((d >> 4) * 4 + tq4) * 16 + (d & 15)) * 8) = w; }
        }
    }
    asm volatile("s_waitcnt lgkmcnt(0)" ::: "memory");
#pragma unroll
    for (int r = 0; r < 4; ++r) {
        const int ur = prep_unit(gidx, r);
        const bool rk = (ur >= 6 && ur < 8) || (ur >= 24 && ur < 30), rv = (ur >= 8 && ur < 10) || (ur >= 14 && ur < 18) || (ur >= 30);
        if (rk) {
            const int kh = (ur < 8) ? (ur - 6) : (ur - 22);
            bf16* dst = KF + ((size_t)tb * 8 + kh) * 1024 + lane * 8;
            const int c0 = lane >> 4, f0 = lane & 15;
            const u32x4v d0 = *(const LAS u32x4v*)(wlds + r * 2048 + (c0 * 16 + (f0 ^ c0)) * 16);
            const u32x4v d1 = *(const LAS u32x4v*)(wlds + r * 2048 + ((c0 + 4) * 16 + (f0 ^ (c0 + 4))) * 16);
            *(u32x4v*)dst = d0; *(u32x4v*)(dst + 512) = d1;
        } else if (rv) {
            const int vh = (ur < 10) ? (ur - 8) : (ur < 18) ? (ur - 12) : (ur - 24);
            bf16* dst = VF + ((size_t)tb * 12 + vh) * 1024 + lane * 8;
            const u32x4v d0 = *(const LAS u32x4v*)(wlds + r * 2048 + lane * 16), d1 = *(const LAS u32x4v*)(wlds + r * 2048 + 1024 + lane * 16);
            *(u32x4v*)dst = d0; *(u32x4v*)(dst + 512) = d1;
        }
    }
    asm volatile("s_waitcnt lgkmcnt(0)" ::: "memory");
}

__device__ __forceinline__ bf16x8 vf_frag(const bf16* p0, const bf16* p1) {
    const u32x2v lo = *(const u32x2v*)p0, hi = *(const u32x2v*)p1;
    u32x4v w; w.x = lo.x; w.y = lo.y; w.z = hi.x; w.w = hi.y; return __builtin_bit_cast(bf16x8, w);
}
__device__ __forceinline__ bf16x8 pack_p(const f32x4& a, const f32x4& b) {
    u32x4v w; w.x = pack2(a.x, a.y); w.y = pack2(a.z, a.w); w.z = pack2(b.x, b.y); w.w = pack2(b.z, b.w); return __builtin_bit_cast(bf16x8, w);
}

__device__ __forceinline__ void dma1k(const bf16* gsrc_lane, LAS unsigned char* ldst) {
    __builtin_amdgcn_global_load_lds((const unsigned*)gsrc_lane, (LAS unsigned*)ldst, 16, 0, 0);
}
__device__ __forceinline__ bf16x8 lds_vfrag(const LAS unsigned char* p0, const LAS unsigned char* p1) {
    const u32x2v lo = *(const LAS u32x2v*)p0, hi = *(const LAS u32x2v*)p1;
    u32x4v w; w.x = lo.x; w.y = lo.y; w.z = hi.x; w.w = hi.y; return __builtin_bit_cast(bf16x8, w);
}

template <bool ROPE> __device__ __forceinline__ void q_prep(bf16x8& q0, bf16x8& q1, const float* g, const float* ropeC, const float* ropeS, int pos, int fq) {
    const u32x4v a = __builtin_bit_cast(u32x4v, q0), b = __builtin_bit_cast(u32x4v, q1);
    float x0[8] = {bf_lo(a.x), bf_hi(a.x), bf_lo(a.y), bf_hi(a.y), bf_lo(a.z), bf_hi(a.z), bf_lo(a.w), bf_hi(a.w)};
    float x1[8] = {bf_lo(b.x), bf_hi(b.x), bf_lo(b.y), bf_hi(b.y), bf_lo(b.z), bf_hi(b.z), bf_lo(b.w), bf_hi(b.w)};
    float ss = 0.f;
#pragma unroll
    for (int j = 0; j < 8; ++j) ss += x0[j] * x0[j] + x1[j] * x1[j];
    ss += __shfl_xor(ss, 16); ss += __shfl_xor(ss, 32);
    const float sc = __builtin_amdgcn_rsqf(ss * (1.f / 64.f) + EPS) * QSCALE;
    const f32x4 g0a = *(const f32x4*)(g + 8 * fq), g0b = *(const f32x4*)(g + 8 * fq + 4), g1a = *(const f32x4*)(g + 32 + 8 * fq), g1b = *(const f32x4*)(g + 36 + 8 * fq);
    const float gv0[8] = {g0a.x, g0a.y, g0a.z, g0a.w, g0b.x, g0b.y, g0b.z, g0b.w}, gv1[8] = {g1a.x, g1a.y, g1a.z, g1a.w, g1b.x, g1b.y, g1b.z, g1b.w};
#pragma unroll
    for (int j = 0; j < 8; ++j) { x0[j] *= sc * gv0[j]; x1[j] *= sc * gv1[j]; }
    if (ROPE) {
        float pr[8];
#pragma unroll
        for (int j = 0; j < 8; ++j) pr[j] = __shfl_xor(x0[j], 16);
        if (fq < 2) {
            const f32x4 ca = *(const f32x4*)(ropeC + pos * 8), cb = *(const f32x4*)(ropeC + pos * 8 + 4), sa = *(const f32x4*)(ropeS + pos * 8), sb = *(const f32x4*)(ropeS + pos * 8 + 4);
            const float cv[8] = {ca.x, ca.y, ca.z, ca.w, cb.x, cb.y, cb.z, cb.w}, sv[8] = {sa.x, sa.y, sa.z, sa.w, sb.x, sb.y, sb.z, sb.w};
            const float sg = (fq == 0) ? -1.f : 1.f;
#pragma unroll
            for (int j = 0; j < 8; ++j) x0[j] = x0[j] * cv[j] + sg * pr[j] * sv[j];
        }
    }
    u32x4v oa, ob;
    oa.x = pack2(x0[0], x0[1]); oa.y = pack2(x0[2], x0[3]); oa.z = pack2(x0[4], x0[5]); oa.w = pack2(x0[6], x0[7]);
    ob.x = pack2(x1[0], x1[1]); ob.y = pack2(x1[2], x1[3]); ob.z = pack2(x1[4], x1[5]); ob.w = pack2(x1[6], x1[7]);
    q0 = __builtin_bit_cast(bf16x8, oa); q1 = __builtin_bit_cast(bf16x8, ob);
}

__device__ __forceinline__ void mixer_b_task(int task, const bf16* P, const bf16* VF, bf16* MIX, const float* w_sp, const float* b_sp, int lane);
__device__ __forceinline__ void mixer_a_item(int idx, const bf16* P, const bf16* KF, const bf16* VF, bf16* MIX, const float* sink, const float* qg, const float* ropeC, LAS unsigned char* lds, int wave, int lane, int btask, const float* w_sp, const float* b_sp) {
    const int blkg = idx >> 1, kvh = idx & 1;
    int n, S, row0;
    if (blkg < 256) { n = blkg & 63; S = 8192; row0 = (blkg >> 6) * 8192; } else { n = blkg - 256; S = 16384; row0 = MP; }
    const int tb0 = (row0 >> 4) + 8 * (n - 1), tblo = row0 >> 4, tbhi = ((row0 + S) >> 4) - 1;
    LAS unsigned char* Kl = lds; LAS unsigned char* Vl = lds + 49152;
#pragma unroll 1
    for (int j = 0; j < 12; ++j) {
        const int i = wave + 8 * j, which = i / 48, rem = i % 48, blk = rem >> 1, half = rem & 1;
        int tb = tb0 + blk; tb = tb < tblo ? tblo : tb; tb = tb > tbhi ? tbhi : tb;
        const bf16* src = which ? VF + ((size_t)tb * 12 + kvh) * 1024 + half * 512 + lane * 8 : KF + ((size_t)tb * 8 + kvh) * 1024 + half * 512 + lane * 8;
        dma1k(src, (which ? Vl : Kl) + blk * 2048 + half * 1024);
    }
    const int fr = lane & 15, fq = lane >> 4;
    const int tq = row0 + 128 * n + 16 * wave;
    bf16x8 qf[3][2];
#pragma unroll
    for (int g = 0; g < 3; ++g) { const bf16* qp = P + (size_t)(tq + fr) * DIN + (kvh * 3 + g) * 64 + 8 * fq; qf[g][0] = *(const bf16x8*)qp; qf[g][1] = *(const bf16x8*)(qp + 32); }
#pragma unroll
    for (int g = 0; g < 3; ++g) q_prep<true>(qf[g][0], qf[g][1], qg, ropeC, ropeC + 16384 * 8, 128 * n + 16 * wave + fr, fq);
    if (btask < 12288) mixer_b_task(btask, P, VF, MIX, w_sp, b_sp, lane);
    asm volatile("s_waitcnt vmcnt(0)" ::: "memory");
    __syncthreads();
#pragma unroll 1
    for (int g = 0; g < 3; ++g) {
        const int head = kvh * 3 + g;
        const bf16x8 q0 = g == 0 ? qf[0][0] : g == 1 ? qf[1][0] : qf[2][0], q1 = g == 0 ? qf[0][1] : g == 1 ? qf[1][1] : qf[2][1];
        f32x4 s[18];
#pragma unroll
        for (int kb = 0; kb < 17; ++kb) {
            int blk = wave + kb; blk = blk > 23 ? 23 : blk;
            const LAS unsigned char* kp = Kl + blk * 2048 + lane * 16;
            const bf16x8 k0 = *(const LAS bf16x8*)kp, k1 = *(const LAS bf16x8*)(kp + 1024);
            f32x4 acc = {0.f, 0.f, 0.f, 0.f};
            acc = mfma16(k0, q0, acc); acc = mfma16(k1, q1, acc); s[kb] = acc;
        }
        const float sk2 = sink[head] * LOG2E;
        float mx = sk2;
#pragma unroll
        for (int kb = 0; kb < 17; ++kb)
#pragma unroll
            for (int i = 0; i < 4; ++i) {
                const int rel = 16 * kb + 4 * fq + i - fr;
                const int kpos = 128 * (n - 1) + (wave + kb) * 16 + 4 * fq + i;
                const bool ok = rel >= 0 && rel <= 256 && kpos >= 0 && kpos < S;
                const float v = ok ? s[kb][i] : -1e30f; s[kb][i] = v; mx = fmaxf(mx, v);
            }
        mx = fmaxf(mx, __shfl_xor(mx, 16)); mx = fmaxf(mx, __shfl_xor(mx, 32));
        float sum = 0.f;
#pragma unroll
        for (int kb = 0; kb < 17; ++kb)
#pragma unroll
            for (int i = 0; i < 4; ++i) { const float pe = __builtin_amdgcn_exp2f(s[kb][i] - mx); s[kb][i] = pe; sum += pe; }
        s[17] = (f32x4){0.f, 0.f, 0.f, 0.f};
        sum += __shfl_xor(sum, 16); sum += __shfl_xor(sum, 32);
        const float inv = 1.f / (sum + __builtin_amdgcn_exp2f(sk2 - mx));
        f32x4 o[4];
#pragma unroll
        for (int db = 0; db < 4; ++db) o[db] = (f32x4){0.f, 0.f, 0.f, 0.f};
#pragma unroll
        for (int pp = 0; pp < 9; ++pp) {
            const bf16x8 pb = pack_p(s[2 * pp], s[2 * pp + 1]);
            int b0 = wave + 2 * pp, b1 = b0 + 1; b0 = b0 > 23 ? 23 : b0; b1 = b1 > 23 ? 23 : b1;
#pragma unroll
            for (int db = 0; db < 4; ++db) o[db] = mfma16(lds_vfrag(Vl + b0 * 2048 + db * 512 + lane * 8, Vl + b1 * 2048 + db * 512 + lane * 8), pb, o[db]);
        }
        bf16* op = MIX + (size_t)(tq + fr) * D + head * 64 + 4 * fq;
#pragma unroll
        for (int db = 0; db < 4; ++db) { const f32x4 v = o[db] * inv; u32x2v wv_; wv_.x = pack2(v.x, v.y); wv_.y = pack2(v.z, v.w); *(u32x2v*)(op + 16 * db) = wv_; }
    }
    __syncthreads();
}

__device__ __forceinline__ void mixer_c_item(int idx, const bf16* P, const bf16* KF, const bf16* VF, bf16* MIX, const float* rel_bias, const float* qg, LAS unsigned char* lds, int tid, int wave, int lane, int btask, const float* w_sp, const float* b_sp) {
    const int rp = idx / 6, h = idx % 6;
    int r0, rows, tok0;
    if (rp < 256) { r0 = 2 * (rp & 63); rows = 128; tok0 = (rp >> 6) * 8192; } else { r0 = 2 * (rp - 256); rows = 256; tok0 = MP; }
    int rs0 = r0 - 4; rs0 = rs0 < 0 ? 0 : rs0; rs0 = rs0 > rows - 8 ? rows - 8 : rs0;
    LAS unsigned char* Kl = lds; LAS unsigned char* Vl = lds + 73728; LAS float* biasL = (LAS float*)(lds + 147456);
#pragma unroll 1
    for (int j = 0; j < 18; ++j) {
        const int i = wave + 8 * j, which = i / 72, rem = i % 72, blk = rem >> 1, half = rem & 1;
        int krow = rs0 + (blk >> 2); krow = krow > rows - 1 ? rows - 1 : krow;
        const int tb = (tok0 >> 4) + krow * 4 + (blk & 3);
        const bf16* src = which ? VF + ((size_t)tb * 12 + 6 + h) * 1024 + half * 512 + lane * 8 : KF + ((size_t)tb * 8 + 2 + h) * 1024 + half * 512 + lane * 8;
        dma1k(src, (which ? Vl : Kl) + blk * 2048 + half * 1024);
    }
    if (tid < 465) biasL[tid] = rel_bias[h * 465 + tid] * LOG2E;
    const int fr = lane & 15, fq = lane >> 4;
    const int r = r0 + (wave >> 2), j = wave & 3;
    int rs = r - 4; rs = rs < 0 ? 0 : rs; rs = rs > rows - 8 ? rows - 8 : rs;
    const int cb0 = j < 2 ? 0 : 1;
    const int qc = 16 * j + fr;
    const int tq = tok0 + r * 64 + 16 * j;
    int cs = qc - 8; cs = cs < 0 ? 0 : cs; cs = cs > 48 ? 48 : cs;
    const bf16* qp = P + (size_t)(tq + fr) * DIN + 1152 + h * 64 + 8 * fq;
    bf16x8 q0 = *(const bf16x8*)qp, q1 = *(const bf16x8*)(qp + 32);
    q_prep<false>(q0, q1, qg, nullptr, nullptr, 0, fq);
    if (btask < 12288) mixer_b_task(btask, P, VF, MIX, w_sp, b_sp, lane);
    asm volatile("s_waitcnt vmcnt(0)" ::: "memory");
    __syncthreads();
    const int lb0 = (rs - rs0) * 4 + cb0;
    f32x4 s[24];
#pragma unroll
    for (int kb = 0; kb < 24; ++kb) {
        const LAS unsigned char* kp = Kl + (lb0 + 4 * (kb / 3) + kb % 3) * 2048 + lane * 16;
        const bf16x8 k0 = *(const LAS bf16x8*)kp, k1 = *(const LAS bf16x8*)(kp + 1024);
        f32x4 acc = {0.f, 0.f, 0.f, 0.f};
        acc = mfma16(k0, q0, acc); acc = mfma16(k1, q1, acc); s[kb] = acc;
    }
    float mx = -1e30f;
#pragma unroll
    for (int kb = 0; kb < 24; ++kb) {
        const int kr = kb / 3, t = kb % 3;
        const int dr = rs + kr - r + 7;
#pragma unroll
        for (int i = 0; i < 4; ++i) {
            const int kc = 16 * (cb0 + t) + 4 * fq + i;
            const bool ok = kc >= cs && kc < cs + 16;
            int dc = kc - qc + 15; dc = dc < 0 ? 0 : dc; dc = dc > 30 ? 30 : dc;
            const float v = ok ? s[kb][i] + biasL[dr * 31 + dc] : -1e30f; s[kb][i] = v; mx = fmaxf(mx, v);
        }
    }
    mx = fmaxf(mx, __shfl_xor(mx, 16)); mx = fmaxf(mx, __shfl_xor(mx, 32));
    float sum = 0.f;
#pragma unroll
    for (int kb = 0; kb < 24; ++kb)
#pragma unroll
        for (int i = 0; i < 4; ++i) { const float pe = __builtin_amdgcn_exp2f(s[kb][i] - mx); s[kb][i] = pe; sum += pe; }
    sum += __shfl_xor(sum, 16); sum += __shfl_xor(sum, 32);
    const float inv = 1.f / sum;
    f32x4 o[4];
#pragma unroll
    for (int db = 0; db < 4; ++db) o[db] = (f32x4){0.f, 0.f, 0.f, 0.f};
#pragma unroll
    for (int pp = 0; pp < 12; ++pp) {
        const bf16x8 pb = pack_p(s[2 * pp], s[2 * pp + 1]);
        const int kb0 = 2 * pp, kb1 = 2 * pp + 1;
        const LAS unsigned char* v0 = Vl + (lb0 + 4 * (kb0 / 3) + kb0 % 3) * 2048 + lane * 8; const LAS unsigned char* v1 = Vl + (lb0 + 4 * (kb1 / 3) + kb1 % 3) * 2048 + lane * 8;
#pragma unroll
        for (int db = 0; db < 4; ++db) o[db] = mfma16(lds_vfrag(v0 + db * 512, v1 + db * 512), pb, o[db]);
    }
    bf16* op = MIX + (size_t)(tq + fr) * D + 640 + h * 64 + 4 * fq;
#pragma unroll
    for (int db = 0; db < 4; ++db) { const f32x4 v = o[db] * inv; u32x2v wv_; wv_.x = pack2(v.x, v.y); wv_.y = pack2(v.z, v.w); *(u32x2v*)(op + 16 * db) = wv_; }
    __syncthreads();
}

__device__ __forceinline__ void mixer_b_task(int task, const bf16* P, const bf16* VF, bf16* MIX, const float* w_sp, const float* b_sp, int lane) {
    const int g = task / 3072, p16 = task % 3072;
    const int fr = lane & 15, fq = lane >> 4;
    const int pt = (p16 & 7) * 16 + fr;
    const int tbc = p16 & ~7;
    const size_t tok = (size_t)p16 * 16 + fr;
    f32x4 wv[4][2];
#pragma unroll
    for (int ks = 0; ks < 4; ++ks) { const float* wp = w_sp + (size_t)(g * 128 + pt) * 128 + 32 * ks + 4 * fq; wv[ks][0] = *(const f32x4*)wp; wv[ks][1] = *(const f32x4*)(wp + 16); }
    const bf16* vfl = VF + ((size_t)tbc * 12 + 2 + g) * 1024 + lane * 4;
    bf16x8 vf[4][4];
#pragma unroll
    for (int ks = 0; ks < 4; ++ks)
#pragma unroll
        for (int eb = 0; eb < 4; ++eb) vf[ks][eb] = vf_frag(vfl + (size_t)(2 * ks) * 12288 + eb * 256, vfl + (size_t)(2 * ks + 1) * 12288 + eb * 256);
    u32x2v uus[4];
#pragma unroll
    for (int eb = 0; eb < 4; ++eb) uus[eb] = *(const u32x2v*)(P + tok * DIN + 640 + g * 64 + 16 * eb + 4 * fq);
    const float bias = b_sp[g * 128 + pt];
    f32x4 d[4];
#pragma unroll
    for (int eb = 0; eb < 4; ++eb) d[eb] = (f32x4){0.f, 0.f, 0.f, 0.f};
#pragma unroll
    for (int ks = 0; ks < 4; ++ks) {
        const bf16x8 bw = pack_p(wv[ks][0], wv[ks][1]);
#pragma unroll
        for (int eb = 0; eb < 4; ++eb) d[eb] = mfma16(vf[ks][eb], bw, d[eb]);
    }
#pragma unroll
    for (int eb = 0; eb < 4; ++eb) {
        const u32x2v uu = uus[eb];
        const float o0 = bf_lo(uu.x) * (d[eb].x + bias), o1 = bf_hi(uu.x) * (d[eb].y + bias), o2 = bf_lo(uu.y) * (d[eb].z + bias), o3 = bf_hi(uu.y) * (d[eb].w + bias);
        u32x2v w; w.x = pack2(o0, o1); w.y = pack2(o2, o3);
        *(u32x2v*)(MIX + tok * D + 384 + g * 64 + 16 * eb + 4 * fq) = w;
    }
}

#define XB_TMO      128
#define XB_XCNT(j)  (256  + 64 * (j))
#define XB_XSUB(j)  (1280 + 64 * (j))
#define XB_XGEN(j)  (2304 + 64 * (j))
#define XB_TOP      3328
#define XB_TOPGEN   3392
#define XCD_BAR_WORDS 3456
#define XB_SPIN_CAP (1u << 18)

__device__ __forceinline__ unsigned xb_ld(unsigned* p)              { return __hip_atomic_load(p, __ATOMIC_RELAXED, __HIP_MEMORY_SCOPE_AGENT); }
__device__ __forceinline__ unsigned xb_add(unsigned* p, unsigned v) { return __hip_atomic_fetch_add(p, v, __ATOMIC_RELAXED, __HIP_MEMORY_SCOPE_AGENT); }
__device__ __forceinline__ unsigned xb_xcc_id() { return (unsigned)__builtin_amdgcn_s_getreg((3 << 11) | 20) & 0xFu; }
#define XB_SPIN(cond, bar) do { unsigned _sp = 0; while (cond) { __builtin_amdgcn_s_sleep(1); \
    if ((++_sp & 255u) == 0u) { if (xb_ld(&(bar)[XB_TMO])) break; if (_sp > XB_SPIN_CAP) { atomicAdd(&(bar)[XB_TMO], 1u); break; } } } } while (0)

struct XcdBarrier {
    unsigned* bar; unsigned x;
    volatile LAS unsigned* st;
};

__device__ __forceinline__ XcdBarrier xcd_barrier_post(unsigned* bar, volatile LAS unsigned* st) {
    XcdBarrier b; b.bar = bar; b.x = xb_xcc_id(); b.st = st;
    if (threadIdx.x == 0) (void)xb_add(&bar[XB_XCNT(b.x)], 1u);
    return b;
}
__device__ __forceinline__ void xcd_barrier_complete(unsigned* bar, unsigned x, unsigned& nloc, unsigned& nx) {
    const unsigned G = gridDim.x * gridDim.y * gridDim.z;
    unsigned sum, cnt, mine, sp = 0u;
    for (;;) {
        sum = 0u; cnt = 0u; mine = 0u;
#pragma unroll
        for (unsigned j = 0; j < 16; ++j) { const unsigned c = xb_ld(&bar[XB_XCNT(j)]); sum += c; cnt += (c > 0u) ? 1u : 0u; mine = (j == x) ? c : mine; }
        if (sum == G) break;
        __builtin_amdgcn_s_sleep(1);
        if ((++sp & 255u) == 0u) { if (xb_ld(&bar[XB_TMO])) break; if (sp > XB_SPIN_CAP) { atomicAdd(&bar[XB_TMO], 1u); break; } }
    }
    nloc = mine > 0u ? mine : 1u; nx = cnt > 0u ? cnt : 1u;
}

__device__ __forceinline__ void xcd_barrier(const XcdBarrier& b) {
    asm volatile("s_waitcnt vmcnt(0)" ::: "memory");
    __syncthreads();
    if (threadIdx.x == 0) {
        unsigned* bar = b.bar;
        __builtin_amdgcn_s_waitcnt(0);
        unsigned nloc = b.st[0], nx = b.st[1];
        if (nloc == 0u) { xcd_barrier_complete(bar, b.x, nloc, nx); b.st[0] = nloc; b.st[1] = nx; }
        const unsigned old = xb_add(&bar[XB_XSUB(b.x)], 1u);
        const unsigned gen = old / nloc;
        if (old + 1u == (gen + 1u) * nloc) {
            __builtin_amdgcn_fence(__ATOMIC_RELEASE, "agent");
            asm volatile("s_waitcnt vmcnt(0)" ::: "memory");
            const unsigned og = xb_add(&bar[XB_TOP], 1u);
            const unsigned tg = og / nx;
            if (og + 1u == (tg + 1u) * nx) xb_add(&bar[XB_TOPGEN], 1u);
            else XB_SPIN(xb_ld(&bar[XB_TOPGEN]) == tg, bar);
            __builtin_amdgcn_fence(__ATOMIC_ACQUIRE, "agent");
            xb_add(&bar[XB_XGEN(b.x)], 1u);
            asm volatile("s_waitcnt vmcnt(0)" ::: "memory");
        } else {
            XB_SPIN(xb_ld(&bar[XB_XGEN(b.x)]) == gen, bar);
            __builtin_amdgcn_fence(__ATOMIC_ACQUIRE, "agent");
            asm volatile("s_waitcnt vmcnt(0)" ::: "memory");
        }
    }
    __syncthreads();
}
__global__ void __launch_bounds__(512, 2) fwd_kernel(Params p_unused) {
    extern __shared__ __attribute__((aligned(16))) unsigned char lds_raw[];
    cg::grid_group grid = cg::this_grid();
    KPtr kp = (KPtr)__builtin_amdgcn_kernarg_segment_ptr();
    LAS unsigned char* lds = (LAS unsigned char*)lds_raw;
    const int wave = __builtin_amdgcn_readfirstlane((int)threadIdx.x >> 6);
#define lane (lane_id_asm())
#define tid (wave * 64 + lane)
#define PH_IDS const int wv = sopaque(wave), bid = sopaque((int)blockIdx.x), G = sopaque((int)gridDim.x), gw = bid * 8 + wv, NGW = G * 8, vcu = (G % 8 == 0) ? (bid % 8) * (G / 8) + bid / 8 : bid, gwx = vcu * 8 + wv; (void)gw; (void)NGW; (void)wv; (void)gwx

    volatile LAS unsigned* bst = (volatile LAS unsigned*)(lds + LDS_BAR_OFF);
    if (tid < 64) bst[tid] = 0u;
    {
        KPtr q = kopaque(kp); unsigned* bw = (unsigned*)(q->ws + WS_BAR);
        if (blockIdx.x == 0) for (int i = tid; i < XCD_BAR_WORDS; i += 512) bw[i] = 0u;
    }
    __syncthreads();
    phase0a(kp, lds, tid, wave, lane);
    grid.sync();
    { KPtr q = kopaque(kp); (void)xcd_barrier_post((unsigned*)(q->ws + WS_BAR), bst); }
#define GRID_BAR() do { XcdBarrier b_; b_.bar = (unsigned*)(kopaque(kp)->ws + WS_BAR); b_.x = xb_xcc_id(); b_.st = (volatile LAS unsigned*)(lds + LDS_BAR_OFF); xcd_barrier(b_); } while (0)
    { PH_IDS; phase0b(kp, lds, gw, NGW, wv, lane); }
    GRID_BAR();

#pragma unroll 1
    for (int l = 0; l < 2; ++l) {
        if (l == 0) {
            PH_IDS; KPtr q = kopaque(kp); unsigned char* ws = q->ws;
            const float* mod = (const float*)(ws + WS_MOD);
            sw_phase(mod, q->w_in, q->w_ff1, (float*)(ws + WS_SW), lds, gw, NGW, wv, lane);
            xa_phase(q->x_prompt, q->x_sample, MP, q->norm1_g, mod + 1 * D, (bf16*)(ws + WS_H), (float*)(ws + WS_RSS), gw, NGW, lane);
            transposes<2>(kp, lds, gw, NGW, wv, lane);
            GRID_BAR();
        }
        {
            PH_IDS; KPtr q = kopaque(kp); unsigned char* ws = q->ws;
            pg8::Gemm g{(const bf16*)(ws + WS_H), (const bf16*)(ws + WS_WIN) + (size_t)l * DIN * D, MTOT, DIN, D}; pg8::StaticOrder S; S.init(MTOT, DIN, G, bid);
            pg8::EpiBf16N<0> E{(bf16*)(ws + WS_PROJ), DIN, (const float*)(ws + WS_RSS) + (size_t)(2 * l) * MTOT, (const float*)(ws + WS_SW) + (size_t)(2 * l) * 5 * 4096, 4096, 0, 640, 1152};
            pg8::gemm_phase<pg8::EpiBf16N<0>, pg8::StaticOrder, true, true>(lds, g, S, E, wv);
        }
        GRID_BAR();
        {
            PH_IDS; KPtr q = kopaque(kp); unsigned char* ws = q->ws;
            const float* ropeC = (const float*)(ws + WS_ROPE);
            bf16* PROJ = (bf16*)(ws + WS_PROJ); bf16* KF = (bf16*)(ws + WS_KF); bf16* VF = (bf16*)(ws + WS_VF);
            const float *ka = q->ka_g + l * 64, *bvg = q->bv_g + l * 256, *kc = q->kc_g + l * 64;
            const int lane_o = vopaque(tid) & 63;
#pragma unroll 1
            for (int task = gwx; task < 15360; task += NGW) prep_task(task, PROJ, KF, VF, ka, bvg, kc, ropeC, ropeC + 16384 * 8, lds + wv * 8192, lane_o);
            __syncthreads();
        }
        GRID_BAR();
        {
        {
            PH_IDS; KPtr q = kopaque(kp); unsigned char* ws = q->ws;
            const bf16* PROJ = (const bf16*)(ws + WS_PROJ); const bf16* KF = (const bf16*)(ws + WS_KF); const bf16* VF = (const bf16*)(ws + WS_VF); bf16* MIXB = (bf16*)(ws + WS_MIX);
            const float* sink = q->a_sink + l * 6; const float* wsp = q->w_sp + (size_t)l * 4 * 128 * 128; const float* bsp = q->b_sp + l * 4 * 128; const float* rb = q->rel_bias + l * 6 * 465;
            const int tid_o = vopaque(tid), lane_o = tid_o & 63;
            int btask = gwx;
#pragma unroll 1
            for (int it = vcu; it < 2304; it += G) { mixer_c_item(it, PROJ, KF, VF, MIXB, rb, q->qc_g + l * 64, lds, tid_o, wv, lane_o, btask, wsp, bsp); btask += NGW; }
#pragma unroll 1
            for (int it = vcu; it < 768; it += G) { mixer_a_item(it, PROJ, KF, VF, MIXB, sink, q->qa_g + l * 64, (const float*)(ws + WS_ROPE), lds, wv, lane_o, btask, wsp, bsp); btask += NGW; }
#pragma unroll 1
            for (; btask < 12288; btask += NGW) mixer_b_task(btask, PROJ, VF, MIXB, wsp, bsp, lane_o);
            __syncthreads();
        }
        }
        GRID_BAR();
        {
            PH_IDS; KPtr q = kopaque(kp); unsigned char* ws = q->ws; float* out = q->out;
            const float* mod_l = (const float*)(ws + WS_MOD) + (size_t)l * 5 * MODW;
            const float* xa = (l == 0) ? q->x_prompt : out; const float* xb = (l == 0) ? q->x_sample : out; const int split = (l == 0) ? MP : (1 << 30);
            pg8::Gemm g{(const bf16*)(ws + WS_MIX), (const bf16*)(ws + WS_WOUT) + (size_t)l * D * D, MTOT, D, D}; pg8::StaticOrder S; S.init(MTOT, D, G, bid);
            pg8::EpiResGateN<false, true> E{xa, xb, split, nullptr, nullptr, (bf16*)(ws + WS_X1B), mod_l + 2 * D, MODW, 0, (bf16*)(ws + WS_H), q->norm2_g + l * D, mod_l + 4 * D, (float*)(ws + WS_RSS) + (size_t)(2 * l + 1) * MTOT, 1};
            pg8::gemm_phase<pg8::EpiResGateN<false, true>, pg8::StaticOrder, true, true>(lds, g, S, E, wv);
        }
        GRID_BAR();
#pragma unroll 1
        for (int ph = 0; ph <= NCHUNK; ++ph) {
#pragma unroll 1
            for (int step = 0; step < 2; ++step) {
            const bool swp = (sopaque((int)blockIdx.x) >> 3) & 1;
            const bool do1 = (step == 0) != swp;
            if (do1 && ph < NCHUNK) {
                const int c = ph;
                PH_IDS; KPtr q = kopaque(kp); unsigned char* ws = q->ws;
                pg8::Gemm g{(const bf16*)(ws + WS_H) + (size_t)c * CHUNK_ROWS * D, (const bf16*)(ws + WS_WFF1) + (size_t)l * DFF * D, CHUNK_ROWS, DFF, D}; pg8::StaticOrder S; S.init(CHUNK_ROWS, DFF, G, bid);
                pg8::EpiBf16N<2> E{(bf16*)(ws + WS_FFH + (size_t)(c & 1) * FFH_BYTES), DFF, (const float*)(ws + WS_RSS) + (size_t)(2 * l + 1) * MTOT, (const float*)(ws + WS_SW) + (size_t)(2 * l + 1) * 5 * 4096, 4096, c * CHUNK_ROWS, 0, 0};
                pg8::gemm_phase<pg8::EpiBf16N<2>, pg8::StaticOrder, true, true>(lds, g, S, E, wv);
            }
            if (!do1 && ph > 0) {
                const int c = ph - 1;
                PH_IDS; KPtr q = kopaque(kp); unsigned char* ws = q->ws; float* out = q->out;
                const float* mod_l = (const float*)(ws + WS_MOD) + (size_t)l * 5 * MODW;
                pg8::Gemm g{(const bf16*)(ws + WS_FFH + (size_t)(c & 1) * FFH_BYTES), (const bf16*)(ws + WS_WFF2) + (size_t)l * D * DFF, CHUNK_ROWS, D, DFF}; pg8::StaticOrder S; S.init(CHUNK_ROWS, D, G, bid);
                const float* mod_n = (const float*)(ws + WS_MOD) + (size_t)1 * 5 * MODW;
                pg8::EpiResGateN<true, false> E{nullptr, nullptr, 0, (const bf16*)(ws + WS_X1B), out, nullptr, mod_l + 5 * D, MODW, c * CHUNK_ROWS, (bf16*)(ws + WS_H), q->norm1_g + 1 * D, mod_n + 1 * D, (float*)(ws + WS_RSS) + (size_t)2 * MTOT, l == 0 ? 1 : 0};
                pg8::gemm_phase<pg8::EpiResGateN<true, false>, pg8::StaticOrder, true, true>(lds, g, S, E, wv);
            }
            }
            if (!(l == 1 && ph == NCHUNK)) GRID_BAR();
        }
    }
#undef lane
#undef tid
}

extern "C" void kernel_launch(void* const* d_in, const int* in_sizes, int n_in, void* d_out, int out_size, void* d_ws, size_t ws_size, hipStream_t stream) {
    static int grid_blocks = 0;
    if (grid_blocks == 0) {
        if (n_in != 21 || ws_size < WS_END) { fprintf(stderr, "kernel_launch: unexpected n_in %d / ws_size %zu\n", n_in, ws_size); grid_blocks = -1; return; }
        int dev = 0, cus = 0, per_cu = 0;
        hipGetDevice(&dev);
        hipDeviceGetAttribute(&cus, hipDeviceAttributeMultiprocessorCount, dev);
        hipFuncSetAttribute((const void*)fwd_kernel, hipFuncAttributeMaxDynamicSharedMemorySize, LDS_BYTES);
        hipOccupancyMaxActiveBlocksPerMultiprocessor(&per_cu, (const void*)fwd_kernel, 512, LDS_BYTES);
        if (per_cu < 1) per_cu = 1;
        grid_blocks = cus * per_cu;
        (void)hipGetLastError();
    }
    if (grid_blocks < 0) return;
    Params p{};
    const float** pp = (const float**)&p;
    for (int i = 0; i < 21; ++i) pp[i] = (const float*)d_in[i];
    p.out = (float*)d_out; p.ws = (unsigned char*)d_ws;
    void* args[] = {&p};
    hipError_t e = hipLaunchCooperativeKernel((const void*)fwd_kernel, dim3(grid_blocks), dim3(512), args, LDS_BYTES, stream);
    if (e != hipSuccess) fprintf(stderr, "cooperative launch failed: %s (grid %d)\n", hipGetErrorString(e), grid_blocks);
}
```

```cpp
#include <hip/hip_runtime.h>
#include <hip/hip_cooperative_groups.h>
#include <cstdio>
#include <cstdint>
namespace cg = cooperative_groups;
__device__ __forceinline__ int lane_id_asm() { int l; asm volatile("v_mbcnt_lo_u32_b32 %0, -1, 0\n\tv_mbcnt_hi_u32_b32 %0, -1, %0" : "=v"(l)); return l; }
namespace pg8 {
#define PG8_LAS __attribute__((address_space(3)))
typedef unsigned short bf16_t;
typedef short bf16x8 __attribute__((ext_vector_type(8)));
typedef float f32x4 __attribute__((ext_vector_type(4)));
typedef unsigned u32x4 __attribute__((ext_vector_type(4)));
constexpr int BM = 256, BK = 64, HALF = 128, HTB = HALF * BK * 2  , STAGE_BYTES = 8 * HTB, NXCD = 8, WGM = 8;

__host__ __device__ __forceinline__ int lds_byte(int r, int c) { const int st = (r >> 4) * 2 + (c >> 5), rr = r & 15, cc = c & 31, ob = rr * 64 + cc * 2; return st * 1024 + (ob ^ (((ob >> 9) & 1) << 5)); }
__host__ __device__ __forceinline__ void stage_rc(int b, int& R, int& C) { const int st = b / 1024, sb = b % 1024, swz = sb ^ (((sb >> 9) & 1) << 5); R = (st >> 1) * 16 + swz / 64; C = (st & 1) * 32 + (swz % 64) / 2; }
__host__ __device__ __forceinline__ int perm32(int rho) { const int n = rho >> 4, i = rho & 15; return 8 * (i >> 2) + 4 * n + (i & 3); }

struct Unit { int pm, pn; };
struct Gemm { const bf16_t* A; const bf16_t* Bt; int M, N, K; };

struct StaticOrder {
    int nM, nN, nwg, G, c;
    __host__ __device__ void init(int M, int N, int G_, int c_) { nM = M / BM; nN = N / BM; nwg = nM * nN; G = G_; c = c_; }
    __host__ __device__ bool next(int i, Unit& u) const {
        const long L = (long)i * G + c; if (L >= nwg) return false;
        int wgid = (int)L; { const int q = nwg / NXCD, r = nwg % NXCD, xcd = wgid % NXCD, off = wgid / NXCD; wgid = (xcd < r ? xcd * (q + 1) : r * (q + 1) + (xcd - r) * q) + off; }
        const int nig = WGM * nN, gid = wgid / nig, fm = gid * WGM, gsz = (nM - fm) < WGM ? (nM - fm) : WGM;
        u.pm = fm + ((wgid % nig) % gsz); u.pn = (wgid % nig) / gsz; return true;
    }
    __device__ __forceinline__ void a_ready(const Unit&) const {}
    __device__ __forceinline__ void done(const Unit&) const {}
};

__device__ __forceinline__ unsigned cvt_pk_bf16(float lo, float hi) { unsigned r; asm volatile("v_cvt_pk_bf16_f32 %0, %1, %2" : "=v"(r) : "v"(lo), "v"(hi)); return r; }
template <int ACT  > struct EpiBf16 {
    static constexpr bool PERM = true, AFTER_DRAIN = false;
    bf16_t* O; int ldc;
    __device__ __forceinline__ void operator()(const f32x4 (&acc)[2][2][4][2], const Unit& u, int wr, int wc, int fr, int fq) const {
        const int row0 = u.pm * BM + wr * 64 + fr; const int col0 = u.pn * BM + wc * 32 + 8 * fq;
#pragma unroll
        for (int ai = 0; ai < 2; ++ai)
#pragma unroll
            for (int m = 0; m < 4; ++m) { bf16_t* rowp = O + (size_t)(row0 + ai * HALF + m * 16) * ldc + col0;
#pragma unroll
                for (int bj = 0; bj < 2; ++bj) { f32x4 v0 = acc[ai][bj][m][0], v1 = acc[ai][bj][m][1];
                    if (ACT == 2) {
#pragma unroll
                        for (int e = 0; e < 4; ++e) { const float a = fmaxf(v0[e], 0.f), b = fmaxf(v1[e], 0.f); v0[e] = a * a; v1[e] = b * b; } }
                    u32x4 w; w.x = cvt_pk_bf16(v0[0], v0[1]); w.y = cvt_pk_bf16(v0[2], v0[3]); w.z = cvt_pk_bf16(v1[0], v1[1]); w.w = cvt_pk_bf16(v1[2], v1[3]);
                    *(u32x4*)(rowp + bj * HALF) = w; } }
    }
};
struct EpiResGate {
    static constexpr bool PERM = false, AFTER_DRAIN = false;
    const float* baseA; const float* baseB; int split; float* out; const float* gate; int gate_stride; int row_off;
    __device__ __forceinline__ void operator()(const f32x4 (&acc)[2][2][4][2], const Unit& u, int wr, int wc, int fr, int fq) const {
        const int R0 = row_off + u.pm * BM; int b = R0 >> 13; b = b > 4 ? 4 : b;
        const float* g = gate + (size_t)b * gate_stride;
        const float* base = (R0 < split) ? baseA + (size_t)R0 * 1024 : baseB + (size_t)(R0 - split) * 1024;
        float* o = out + (size_t)R0 * 1024;
        const int col0 = u.pn * BM + wc * 32 + 4 * fq;
        f32x4 gv[2][2];
#pragma unroll
        for (int bj = 0; bj < 2; ++bj)
#pragma unroll
            for (int n = 0; n < 2; ++n) gv[bj][n] = *(const f32x4*)(g + col0 + bj * HALF + n * 16);
#pragma unroll
        for (int ai = 0; ai < 2; ++ai)
#pragma unroll
            for (int m = 0; m < 4; ++m) { const size_t off = (size_t)(ai * HALF + wr * 64 + m * 16 + fr) * 1024 + col0;
#pragma unroll
                for (int bj = 0; bj < 2; ++bj)
#pragma unroll
                    for (int n = 0; n < 2; ++n) { const f32x4 bs = *(const f32x4*)(base + off + bj * HALF + n * 16);
                        *(f32x4*)(o + off + bj * HALF + n * 16) = bs + gv[bj][n] * acc[ai][bj][m][n]; } }
    }
};

__device__ __forceinline__ float gelu_t(float x) { const float u = 0.7978845608028654f * (x + 0.044715f * x * x * x); return x * __builtin_amdgcn_rcpf(1.f + __builtin_amdgcn_exp2f(-2.8853900817779268f * u)); }
template <int ACT  > struct EpiBf16N {
    static constexpr bool PERM = true, AFTER_DRAIN = false;
    bf16_t* O; int ldc; const float* rowss; const float* bias; int ldb; int row_off; int gelu_lo, gelu_hi;
    __device__ __forceinline__ void operator()(const f32x4 (&acc)[2][2][4][2], const Unit& u, int wr, int wc, int fr, int fq) const {
        int zz = 0; asm volatile("" : "+v"(zz));
        const int R0 = row_off + u.pm * BM; int b = R0 >> 13; b = b > 4 ? 4 : b;
        const int lrow0 = u.pm * BM + wr * 64 + fr + zz; const int col0 = u.pn * BM + wc * 32 + 8 * fq + zz;
        const float* rss0_ = rowss; bf16_t* O0_ = O; const float* bias0_ = bias; asm volatile("" : "+s"(rss0_), "+s"(O0_), "+s"(bias0_));
        typedef __attribute__((address_space(1))) const float gcf; typedef __attribute__((address_space(1))) bf16_t gbf;
        gcf* rss_ = (gcf*)rss0_; gbf* O_ = (gbf*)O0_; gcf* bias_ = (gcf*)bias0_;
        gcf* bp = bias_ + (size_t)b * ldb + col0;
        f32x4 bv[2][2];
#pragma unroll
        for (int bj = 0; bj < 2; ++bj)
#pragma unroll
            for (int n = 0; n < 2; ++n) bv[bj][n] = *(const __attribute__((address_space(1))) f32x4*)(bp + bj * HALF + 4 * n);
        float rinvs[2][4];
#pragma unroll
        for (int ai = 0; ai < 2; ++ai)
#pragma unroll
            for (int m = 0; m < 4; ++m) rinvs[ai][m] = rss_[row_off + lrow0 + ai * HALF + m * 16];
#pragma unroll
        for (int ai = 0; ai < 2; ++ai)
#pragma unroll
            for (int m = 0; m < 4; ++m) { const int lr = lrow0 + ai * HALF + m * 16; gbf* rowp = O_ + (size_t)lr * ldc + col0;
                const float rinv = rsqrtf(rinvs[ai][m] * (1.f / 1024.f) + 1e-6f);
#pragma unroll
                for (int bj = 0; bj < 2; ++bj) { f32x4 v0 = acc[ai][bj][m][0] * rinv + bv[bj][0], v1 = acc[ai][bj][m][1] * rinv + bv[bj][1];
                    if (ACT == 2) {
#pragma unroll
                        for (int e = 0; e < 4; ++e) { const float a = fmaxf(v0[e], 0.f), b2 = fmaxf(v1[e], 0.f); v0[e] = a * a; v1[e] = b2 * b2; } }
                    if (ACT == 0) { const int cb = u.pn * BM + bj * HALF; if (cb >= gelu_lo && cb < gelu_hi) {
#pragma unroll
                        for (int e = 0; e < 4; ++e) { v0[e] = gelu_t(v0[e]); v1[e] = gelu_t(v1[e]); } } }
                    u32x4 w; w.x = cvt_pk_bf16(v0[0], v0[1]); w.y = cvt_pk_bf16(v0[2], v0[3]); w.z = cvt_pk_bf16(v1[0], v1[1]); w.w = cvt_pk_bf16(v1[2], v1[3]);
                    *(__attribute__((address_space(1))) u32x4*)(rowp + bj * HALF) = w; } }
    }
};
template <bool BASE_BF16  , bool OUT_BF16  > struct EpiResGateN {
    static constexpr bool PERM = true, AFTER_DRAIN = false;
    const float* baseA; const float* baseB; int split; const bf16_t* baseH; float* out; bf16_t* outH; const float* gate; int gate_stride; int row_off;
    bf16_t* XA; const float* ag; const float* ascale; float* rss; int do_next;
    __device__ __forceinline__ void operator()(const f32x4 (&acc)[2][2][4][2], const Unit& u, int wr, int wc, int fr, int fq) const {
        const int R0 = row_off + u.pm * BM; int b = R0 >> 13; b = b > 4 ? 4 : b;
        const float* g = gate + (size_t)b * gate_stride;
        const float* base = BASE_BF16 ? (const float*)nullptr : ((R0 < split) ? baseA + (size_t)R0 * 1024 : baseB + (size_t)(R0 - split) * 1024);
        const bf16_t* baseh = BASE_BF16 ? baseH + (size_t)R0 * 1024 : (const bf16_t*)nullptr;
        float* o = OUT_BF16 ? (float*)nullptr : out + (size_t)R0 * 1024; bf16_t* oh = OUT_BF16 ? outH + (size_t)R0 * 1024 : (bf16_t*)nullptr;
        bf16_t* xa_ = XA + (size_t)R0 * 1024; float* rss_ = rss + R0;
        asm volatile("" : "+s"(g), "+s"(base), "+s"(baseh), "+s"(o), "+s"(oh), "+s"(xa_), "+s"(rss_));
        typedef __attribute__((address_space(1))) const f32x4 gcv4; typedef __attribute__((address_space(1))) f32x4 gv4; typedef __attribute__((address_space(1))) const u32x4 gcu4; typedef __attribute__((address_space(1))) u32x4 gu4;
        const __attribute__((address_space(1))) float* gg_ = (const __attribute__((address_space(1))) float*)g; const __attribute__((address_space(1))) float* gbase = (const __attribute__((address_space(1))) float*)base;
        const __attribute__((address_space(1))) bf16_t* gbaseh = (const __attribute__((address_space(1))) bf16_t*)baseh;
        __attribute__((address_space(1))) float* go = (__attribute__((address_space(1))) float*)o; __attribute__((address_space(1))) bf16_t* goh = (__attribute__((address_space(1))) bf16_t*)oh;
        __attribute__((address_space(1))) bf16_t* gxa = (__attribute__((address_space(1))) bf16_t*)xa_; __attribute__((address_space(1))) float* grss = (__attribute__((address_space(1))) float*)rss_;
        const __attribute__((address_space(1))) float* gag = (const __attribute__((address_space(1))) float*)ag; const __attribute__((address_space(1))) float* gasc = (const __attribute__((address_space(1))) float*)ascale;
        int zz = 0; asm volatile("" : "+v"(zz));
        const int col0 = u.pn * BM + wc * 32 + 8 * fq + zz;
        f32x4 gv[2][2], av[2][2];
#pragma unroll
        for (int bj = 0; bj < 2; ++bj)
#pragma unroll
            for (int n = 0; n < 2; ++n) { gv[bj][n] = *(gcv4*)(gg_ + col0 + bj * HALF + n * 4);
                if (do_next) av[bj][n] = *(gcv4*)(gag + col0 + bj * HALF + n * 4) * (*(gcv4*)(gasc + (size_t)b * gate_stride + col0 + bj * HALF + n * 4) + 1.f);
                else av[bj][n] = (f32x4){0.f, 0.f, 0.f, 0.f}; }
        f32x4 bs[2][2][2]; u32x4 bsh[2][2];
        const unsigned rc0 = (unsigned)(wr * 64 + fr + zz) * 1024u + (unsigned)col0;
#define RG_LOAD(rg, buf) do { const unsigned off_ = rc0 + (unsigned)(((rg) >> 2) * HALF + ((rg) & 3) * 16) * 1024u; \
        if (BASE_BF16) { _Pragma("unroll") for (int bj = 0; bj < 2; ++bj) bsh[buf][bj] = *(gcu4*)(gbaseh + off_ + bj * HALF); } \
        else { _Pragma("unroll") for (int bj = 0; bj < 2; ++bj) _Pragma("unroll") for (int n = 0; n < 2; ++n) bs[buf][bj][n] = *(gcv4*)(gbase + off_ + bj * HALF + n * 4); } } while (0)
        RG_LOAD(0, 0);
#pragma unroll
        for (int rg = 0; rg < 8; ++rg) {
            const int ai = rg >> 2, m = rg & 3;
            if (rg + 1 < 8) RG_LOAD(rg + 1, (rg + 1) & 1);
            __builtin_amdgcn_sched_barrier(0);
            const int r = ai * HALF + wr * 64 + m * 16 + fr; const unsigned off = rc0 + (unsigned)(ai * HALF + m * 16) * 1024u; float ssq = 0.f;
#pragma unroll
            for (int bj = 0; bj < 2; ++bj) { f32x4 x[2];
                if (BASE_BF16) { const u32x4 h = bsh[rg & 1][bj];
                    const f32x4 b0 = {__uint_as_float(h.x << 16), __uint_as_float(h.x & 0xffff0000u), __uint_as_float(h.y << 16), __uint_as_float(h.y & 0xffff0000u)};
                    const f32x4 b1 = {__uint_as_float(h.z << 16), __uint_as_float(h.z & 0xffff0000u), __uint_as_float(h.w << 16), __uint_as_float(h.w & 0xffff0000u)};
                    x[0] = b0 + gv[bj][0] * acc[ai][bj][m][0]; x[1] = b1 + gv[bj][1] * acc[ai][bj][m][1];
                } else {
#pragma unroll
                    for (int n = 0; n < 2; ++n) x[n] = bs[rg & 1][bj][n] + gv[bj][n] * acc[ai][bj][m][n];
                }
                if (OUT_BF16) { u32x4 w; w.x = cvt_pk_bf16(x[0][0], x[0][1]); w.y = cvt_pk_bf16(x[0][2], x[0][3]); w.z = cvt_pk_bf16(x[1][0], x[1][1]); w.w = cvt_pk_bf16(x[1][2], x[1][3]);
                    *(gu4*)(goh + off + bj * HALF) = w;
                } else {
#pragma unroll
                    for (int n = 0; n < 2; ++n) *(gv4*)(go + off + bj * HALF + n * 4) = x[n];
                }
                if (do_next) { ssq += ((x[0][0] * x[0][0] + x[0][1] * x[0][1]) + (x[0][2] * x[0][2] + x[0][3] * x[0][3])) + ((x[1][0] * x[1][0] + x[1][1] * x[1][1]) + (x[1][2] * x[1][2] + x[1][3] * x[1][3]));
                    const f32x4 y0 = x[0] * av[bj][0], y1 = x[1] * av[bj][1];
                    u32x4 w; w.x = cvt_pk_bf16(y0[0], y0[1]); w.y = cvt_pk_bf16(y0[2], y0[3]); w.z = cvt_pk_bf16(y1[0], y1[1]); w.w = cvt_pk_bf16(y1[2], y1[3]);
                    *(gu4*)(gxa + off + bj * HALF) = w; } }
            if (do_next) { ssq += __shfl_xor(ssq, 16); ssq += __shfl_xor(ssq, 32);
                if (fq == 0) __hip_atomic_fetch_add((float*)(grss + r), ssq, __ATOMIC_RELAXED, __HIP_MEMORY_SCOPE_AGENT); }
            __builtin_amdgcn_sched_barrier(0);
        }
#undef RG_LOAD
    }
};
template <class Epi, class Sched, bool ALIGN_EPI = false, bool SP2 = false>
__device__ __forceinline__ void gemm_phase(PG8_LAS unsigned char* lds, const Gemm g, const Sched& S, const Epi& E, int wave_in) {
    int tid_ = wave_in * 64 + ::lane_id_asm();
    const int tid = tid_, wid = __builtin_amdgcn_readfirstlane(tid >> 6), lane = tid & 63, wr = wid >> 2, wc = wid & 3, fr = lane & 15, fq = lane >> 4;
    const int K = g.K, nt = K / BK;
    unsigned voffA[2], voffB[2];
#pragma unroll
    for (int i = 0; i < 2; ++i) { int R, C; stage_rc(tid * 16 + i * 8192, R, C); const int Rb = Epi::PERM ? ((R & ~31) + perm32(R & 31)) : R;
        voffA[i] = (unsigned)(R * K + C) * 2u; voffB[i] = (unsigned)(Rb * K + C) * 2u; }
    const size_t kstep = (size_t)(BK * 2);
    const size_t hstep = (size_t)HALF * K * 2;
    const size_t tstep = 2 * hstep;
    const unsigned ldsw = (unsigned)wid * 1024u;
    const int aoff = lds_byte(wr * 64 + fr, fq * 8), boff = lds_byte(wc * 32 + fr, fq * 8);
#define PG8_SA(b, h) (((b) * 2 + (h)) * HTB)
#define PG8_SB(b, h) ((4 + (b) * 2 + (h)) * HTB)
#define PG8_STAGE(bufoff, gbase, voff) do { _Pragma("unroll") for (int _i = 0; _i < 2; ++_i) \
        __builtin_amdgcn_global_load_lds((const unsigned*)((const char*)(gbase) + (voff)[_i]), (PG8_LAS unsigned*)(lds + (bufoff) + ldsw + _i * 8192), 16, 0, 0); } while (0)
#define PG8_LDA(dst, b, h) do { _Pragma("unroll") for (int m = 0; m < 4; ++m) _Pragma("unroll") for (int k = 0; k < 2; ++k) dst[m][k] = *(const PG8_LAS bf16x8*)(lds + PG8_SA(b, h) + aoff + m * 2048 + k * 1024); } while (0)
#define PG8_LDB(dst, b, h) do { _Pragma("unroll") for (int n = 0; n < 2; ++n) _Pragma("unroll") for (int k = 0; k < 2; ++k) dst[n][k] = *(const PG8_LAS bf16x8*)(lds + PG8_SB(b, h) + boff + n * 2048 + k * 1024); } while (0)
#define PG8_MMA(ai, bj, At, Bt) do { __builtin_amdgcn_s_setprio(1); _Pragma("unroll") for (int m = 0; m < 4; ++m) _Pragma("unroll") for (int n = 0; n < 2; ++n) _Pragma("unroll") for (int k = 0; k < 2; ++k) \
        acc[ai][bj][m][n] = __builtin_amdgcn_mfma_f32_16x16x32_bf16(Bt[n][k], At[m][k], acc[ai][bj][m][n], 0, 0, 0); __builtin_amdgcn_s_setprio(0); } while (0)
#define PG8_WAIT_V(n) asm volatile("s_waitcnt vmcnt(" #n ")" ::: "memory")
#define PG8_WAIT_L(n) asm volatile("s_waitcnt lgkmcnt(" #n ")" ::: "memory")
#define PG8_BAR __builtin_amdgcn_s_barrier()
#define PG8_SCHED __builtin_amdgcn_sched_barrier(0)
    Unit cur, nxt; int ui = 0;
    if (!S.next(0, cur)) return;
    f32x4 acc[2][2][4][2];
#pragma unroll
    for (int a = 0; a < 2; ++a)
#pragma unroll
        for (int b = 0; b < 2; ++b)
#pragma unroll
            for (int m = 0; m < 4; ++m)
#pragma unroll
                for (int n = 0; n < 2; ++n) acc[a][b][m][n] = (f32x4){0.f, 0.f, 0.f, 0.f};
    bf16x8 At[4][2], B0[2][2], B1[2][2];
    const char* cA = (const char*)g.A + (size_t)cur.pm * tstep; const char* cB = (const char*)g.Bt + (size_t)cur.pn * tstep;
    S.a_ready(cur);
    if constexpr (SP2) {
        PG8_STAGE(PG8_SB(0, 0), cB, voffB); PG8_STAGE(PG8_SB(0, 1), cB + hstep, voffB); PG8_STAGE(PG8_SA(0, 0), cA, voffA); PG8_STAGE(PG8_SA(0, 1), cA + hstep, voffA);
        if (wr == 1) PG8_BAR;
        PG8_WAIT_V(2); PG8_BAR;
        PG8_STAGE(PG8_SB(1, 0), cB + kstep, voffB); PG8_STAGE(PG8_SA(1, 0), cA + kstep, voffA); PG8_STAGE(PG8_SB(1, 1), cB + hstep + kstep, voffB);
        PG8_WAIT_V(6); PG8_BAR;
    } else {
        PG8_STAGE(PG8_SB(0, 0), cB, voffB); PG8_STAGE(PG8_SA(0, 0), cA, voffA); PG8_STAGE(PG8_SB(0, 1), cB + hstep, voffB); PG8_STAGE(PG8_SA(0, 1), cA + hstep, voffA);
        if (wr == 1) PG8_BAR;
        PG8_WAIT_V(4); PG8_BAR;
        PG8_STAGE(PG8_SB(1, 0), cB + kstep, voffB); PG8_STAGE(PG8_SA(1, 0), cA + kstep, voffA); PG8_STAGE(PG8_SB(1, 1), cB + hstep + kstep, voffB);
        PG8_WAIT_V(6); PG8_BAR;
    }
    for (;;) {
        const bool has_next = S.next(ui + 1, nxt);
        const char* nA = has_next ? (const char*)g.A + (size_t)nxt.pm * tstep : cA; const char* nB = has_next ? (const char*)g.Bt + (size_t)nxt.pn * tstep : cB;
        for (int t = 0; t < nt; t += 2) {
            const bool last = (t == nt - 2);
            const char* a1 = cA + (size_t)(t + 1) * kstep;
            const char* a2 = last ? nA : cA + (size_t)(t + 2) * kstep; const char* b2 = last ? nB : cB + (size_t)(t + 2) * kstep;
            const char* a3 = a2 + kstep; const char* b3 = b2 + kstep;
            if (last && has_next) S.a_ready(nxt);
            if constexpr (SP2) {
            PG8_LDB(B0, 0, 0); PG8_LDB(B1, 0, 1); PG8_SCHED; PG8_LDA(At, 0, 0); PG8_STAGE(PG8_SA(1, 1), a1 + hstep, voffA);
            PG8_WAIT_V(8); PG8_WAIT_L(0); PG8_BAR; PG8_MMA(0, 0, At, B0); PG8_MMA(0, 1, At, B1); PG8_BAR; PG8_SCHED;
            PG8_LDA(At, 0, 1); PG8_STAGE(PG8_SB(0, 0), b2, voffB); PG8_STAGE(PG8_SB(0, 1), b2 + hstep, voffB); PG8_STAGE(PG8_SA(0, 0), a2, voffA);
            PG8_WAIT_V(8); PG8_WAIT_L(0); PG8_BAR; PG8_MMA(1, 0, At, B0); PG8_MMA(1, 1, At, B1); PG8_BAR; PG8_SCHED;
            PG8_LDB(B0, 1, 0); PG8_LDB(B1, 1, 1); PG8_SCHED; PG8_LDA(At, 1, 0); PG8_STAGE(PG8_SA(0, 1), a2 + hstep, voffA);
            PG8_WAIT_V(8); PG8_WAIT_L(0); PG8_BAR; PG8_MMA(0, 0, At, B0); PG8_MMA(0, 1, At, B1); PG8_BAR; PG8_SCHED;
            PG8_LDA(At, 1, 1); PG8_STAGE(PG8_SB(1, 0), b3, voffB); PG8_STAGE(PG8_SB(1, 1), b3 + hstep, voffB); PG8_STAGE(PG8_SA(1, 0), a3, voffA);
            PG8_WAIT_V(8); PG8_WAIT_L(0); PG8_BAR; PG8_MMA(1, 0, At, B0); PG8_MMA(1, 1, At, B1); PG8_BAR; PG8_SCHED;
            } else {
            PG8_LDB(B0, 0, 0); PG8_SCHED; PG8_LDA(At, 0, 0); PG8_STAGE(PG8_SA(1, 1), a1 + hstep, voffA);
            PG8_WAIT_L(8); PG8_BAR; PG8_WAIT_L(0); PG8_MMA(0, 0, At, B0); PG8_BAR; PG8_SCHED;
            PG8_LDB(B1, 0, 1); PG8_STAGE(PG8_SB(0, 0), b2, voffB);
            PG8_BAR; PG8_WAIT_L(0); PG8_MMA(0, 1, At, B1); PG8_BAR;
            PG8_LDA(At, 0, 1); PG8_STAGE(PG8_SA(0, 0), a2, voffA);
            PG8_BAR; PG8_WAIT_L(0); PG8_MMA(1, 0, At, B0); PG8_BAR; PG8_SCHED;
            PG8_STAGE(PG8_SB(0, 1), b2 + hstep, voffB);
            PG8_WAIT_V(6); PG8_BAR; PG8_MMA(1, 1, At, B1); PG8_BAR;
            PG8_LDB(B0, 1, 0); PG8_SCHED; PG8_LDA(At, 1, 0); PG8_STAGE(PG8_SA(0, 1), a2 + hstep, voffA);
            PG8_WAIT_L(8); PG8_BAR; PG8_WAIT_L(0); PG8_MMA(0, 0, At, B0); PG8_BAR; PG8_SCHED;
            PG8_LDB(B1, 1, 1); PG8_STAGE(PG8_SB(1, 0), b3, voffB);
            PG8_BAR; PG8_WAIT_L(0); PG8_MMA(0, 1, At, B1); PG8_BAR;
            PG8_LDA(At, 1, 1); PG8_STAGE(PG8_SA(1, 0), a3, voffA);
            PG8_BAR; PG8_WAIT_L(0); PG8_MMA(1, 0, At, B0); PG8_BAR; PG8_SCHED;
            PG8_STAGE(PG8_SB(1, 1), b3 + hstep, voffB);
            PG8_WAIT_V(6); PG8_BAR; PG8_MMA(1, 1, At, B1); PG8_BAR;
            }
        }
        if constexpr (ALIGN_EPI) { if (wr == 0) PG8_BAR; }
        if constexpr (!Epi::AFTER_DRAIN) { E(acc, cur, wr, wc, fr, fq); S.done(cur); }
        if (!has_next) break;
#pragma unroll
        for (int a = 0; a < 2; ++a)
#pragma unroll
            for (int b = 0; b < 2; ++b)
#pragma unroll
                for (int m = 0; m < 4; ++m)
#pragma unroll
                    for (int n = 0; n < 2; ++n) acc[a][b][m][n] = (f32x4){0.f, 0.f, 0.f, 0.f};
        cur = nxt; cA = nA; cB = nB; ++ui;
        if constexpr (ALIGN_EPI) { if (wr == 1) PG8_BAR; }
    }
    PG8_WAIT_V(0);
    if constexpr (!ALIGN_EPI) { if (wr == 0) PG8_BAR; }
    PG8_BAR;
    if constexpr (Epi::AFTER_DRAIN) { E.fused(acc, cur, wr, wc, fr, fq, lds, wid, lane); S.done(cur); }
#undef PG8_SA
#undef PG8_SB
#undef PG8_STAGE
#undef PG8_LDA
#undef PG8_LDB
#undef PG8_MMA
#undef PG8_WAIT_V
#undef PG8_WAIT_L
#undef PG8_BAR
#undef PG8_SCHED
}
}

#define LAS __attribute__((address_space(3)))
typedef unsigned short bf16;
typedef short bf16x8 __attribute__((ext_vector_type(8)));
typedef float f32x4 __attribute__((ext_vector_type(4)));
typedef unsigned u32x4v __attribute__((ext_vector_type(4)));
typedef unsigned u32x2v __attribute__((ext_vector_type(2)));

constexpr int D = 1024, DIN = 2304, DFF = 4096, MTOT = 49152, MP = 32768, MODW = 6144;
constexpr int CHUNK_ROWS = 16384, NCHUNK = 3;
constexpr float EPS = 1e-6f, LOG2E = 1.4426950408889634f, QSCALE = 0.125f * 1.4426950408889634f;
constexpr int LDS_BAR_OFF = 153344;
constexpr int LDS_BYTES = 153600;
constexpr size_t WS_BAR = 0;
constexpr size_t MiB = 1u << 20;
constexpr size_t WS_WIN = 1 * MiB, WS_WOUT = 10 * MiB, WS_WFF1 = 14 * MiB, WS_WFF2 = 30 * MiB, WS_MOD = 46 * MiB, WS_ROPE = 47 * MiB;
constexpr size_t WS_H = 48 * MiB, WS_PROJ = 144 * MiB, WS_MIX = 360 * MiB;
constexpr size_t WS_X1B = 144 * MiB  , WS_FFH = 240 * MiB  ;
constexpr size_t WS_RSS = 46 * MiB + 256 * 1024  , WS_SW = 64 * 1024  ;
constexpr size_t FFH_BYTES = 128 * MiB;
constexpr size_t WS_VF = WS_H  , WS_KF = 456 * MiB, WS_END = 504 * MiB;

struct Params {
    const float *x_prompt, *x_sample, *c_prompt, *c_sample, *norm1_g, *norm2_g, *w_ada, *b_ada, *w_in, *qa_g, *ka_g, *a_sink, *bv_g, *w_sp, *b_sp,
        *qc_g, *kc_g, *rel_bias, *w_out, *w_ff1, *w_ff2;
    float* out; unsigned char* ws;
};

__device__ __forceinline__ float bf_lo(unsigned w) { return __uint_as_float(w << 16); }
__device__ __forceinline__ float bf_hi(unsigned w) { return __uint_as_float(w & 0xffff0000u); }
__device__ __forceinline__ unsigned pack2(float lo, float hi) { return pg8::cvt_pk_bf16(lo, hi); }
__device__ __forceinline__ float wave_sum(float v) {
#pragma unroll
    for (int o = 1; o < 64; o <<= 1) v += __shfl_xor(v, o);
    return v;
}
__device__ __forceinline__ float gelu_tanh(float x) {
    const float u = 0.7978845608028654f * (x + 0.044715f * x * x * x);
    return x * __builtin_amdgcn_rcpf(1.f + __builtin_amdgcn_exp2f(-2.f * LOG2E * u));
}
template <int CTRL> __device__ __forceinline__ float dpp_f(float v) { return __builtin_bit_cast(float, __builtin_amdgcn_update_dpp(0, __builtin_bit_cast(int, v), CTRL, 0xf, 0xf, false)); }
__device__ __forceinline__ float sum16(float s) {
    s += dpp_f<0xB1>(s); s += dpp_f<0x4E>(s); s += dpp_f<0x141>(s); s += dpp_f<0x140>(s); return s;
}
__device__ __forceinline__ f32x4 mfma16(bf16x8 a, bf16x8 b, f32x4 c) { return __builtin_amdgcn_mfma_f32_16x16x32_bf16(a, b, c, 0, 0, 0); }

__device__ __forceinline__ void transpose_item(const float* W, int K, int N, bf16* WT, LAS float* scr, int item, int lane) {
    const int nblk = N / 32, kb = item / nblk, nb = item % nblk, k0 = 64 * kb, n0 = 32 * nb;
#pragma unroll 8
    for (int i = 0; i < 32; ++i) { const int kk = 2 * i + (lane >> 5); scr[kk * 33 + (lane & 31)] = W[(size_t)(k0 + kk) * N + n0 + (lane & 31)]; }
    asm volatile("s_waitcnt lgkmcnt(0)" ::: "memory");
    const int c = lane & 7;
#pragma unroll
    for (int j = 0; j < 4; ++j) { const int n = (lane >> 3) + 8 * j; const LAS float* s = scr + (8 * c) * 33 + n;
        u32x4v o; o.x = pack2(s[0 * 33], s[1 * 33]); o.y = pack2(s[2 * 33], s[3 * 33]); o.z = pack2(s[4 * 33], s[5 * 33]); o.w = pack2(s[6 * 33], s[7 * 33]);
        *(u32x4v*)(WT + (size_t)(n0 + n) * K + k0 + 8 * c) = o; }
    asm volatile("s_waitcnt lgkmcnt(0)" ::: "memory");
}

__device__ __forceinline__ int vopaque(int v) { asm volatile("" : "+v"(v)); return v; }
__device__ __forceinline__ int sopaque(int v) { asm volatile("" : "+s"(v)); return v; }
typedef const __attribute__((address_space(4))) Params* KPtr;
__device__ __forceinline__ KPtr kopaque(KPtr q) { asm volatile("" : "+s"(q)); return q; }
template <int SEL> __device__ __forceinline__ void transposes(KPtr kp, LAS unsigned char* lds, int gw, int NGW, int wave, int lane) {
    KPtr p = kopaque(kp); unsigned char* ws = p->ws;
    LAS float* scr = (LAS float*)(lds + wave * 16384);
    constexpr int I_IN = 16 * 72, I_OUT = 16 * 32, I_F1 = 16 * 128, I_F2 = 64 * 32;
    if (SEL == 0) { for (int it = gw; it < 2 * I_IN; it += NGW) { const int l = it / I_IN, r = it % I_IN;
        transpose_item(p->w_in + (size_t)l * D * DIN, D, DIN, (bf16*)(ws + WS_WIN) + (size_t)l * DIN * D, scr, r, lane); } }
    if (SEL == 1) { for (int it = gw; it < 2 * I_OUT; it += NGW) { const int l = it / I_OUT, r = it % I_OUT;
        transpose_item(p->w_out + (size_t)l * D * D, D, D, (bf16*)(ws + WS_WOUT) + (size_t)l * D * D, scr, r, lane); } }
    if (SEL == 2) { for (int it = gw; it < 2 * (I_F1 + I_F2); it += NGW) { const int l = it / (I_F1 + I_F2), r = it % (I_F1 + I_F2);
        if (r < I_F1) transpose_item(p->w_ff1 + (size_t)l * D * DFF, D, DFF, (bf16*)(ws + WS_WFF1) + (size_t)l * DFF * D, scr, r, lane);
        else transpose_item(p->w_ff2 + (size_t)l * DFF * D, DFF, D, (bf16*)(ws + WS_WFF2) + (size_t)l * D * DFF, scr, r - I_F1, lane); } }
}
__device__ __forceinline__ void phase0a(KPtr kp, LAS unsigned char* lds, int tid, int wave, int lane) {
    KPtr p = kopaque(kp); unsigned char* ws = p->ws;
    {
        float* z0 = (float*)(ws + WS_MOD); float* z1 = (float*)(ws + WS_SW);
        for (int i = blockIdx.x * 512 + tid; i < (1 << 18); i += gridDim.x * 512) z0[i] = 0.f;
        for (int i = blockIdx.x * 512 + tid; i < 4 * 5 * 4096; i += gridDim.x * 512) z1[i] = 0.f;
    }
    {
        float* rc = (float*)(ws + WS_ROPE); float* rs = rc + 16384 * 8;
        for (int i = blockIdx.x * 512 + tid; i < 16384 * 8; i += gridDim.x * 512) {
            const int pos = i >> 3, f = i & 7;
            const float inv = f == 0 ? 1.0f : f == 1 ? 0.19392274474868576f : f == 2 ? 0.03760603093086393f : f == 3 ? 0.007292664737217109f :
                              f == 4 ? 0.001414213562373095f : f == 5 ? 0.0002742481756762073f : f == 6 ? 5.318295896944988e-05f : 1.031338537721246e-05f;
            const float ang = (float)pos * inv;
            double rev = (double)ang * 0.15915494309189535; rev -= __builtin_floor(rev);
            rc[i] = __builtin_amdgcn_cosf((float)rev); rs[i] = __builtin_amdgcn_sinf((float)rev);
        }
    }
    transposes<0>(kp, lds, blockIdx.x * 8 + wave, gridDim.x * 8, wave, lane);
}
__device__ __forceinline__ void phase0b(KPtr kp, LAS unsigned char* lds, int gw, int NGW, int wave, int lane) {
    KPtr p = kopaque(kp); unsigned char* ws = p->ws;
    float* mod = (float*)(ws + WS_MOD);
    LAS float* sl = (LAS float*)(lds + wave * 16384);
    for (int item = gw; item < 1536; item += NGW) {
        const int ks = item & 7, r = item >> 3, l = r / 96, col0 = (r % 96) * 64;
        for (int i = lane; i < 640; i += 64) { const int b = i >> 7, k = ks * 128 + (i & 127); const float c = (b < 4) ? p->c_prompt[b * 1024 + k] : p->c_sample[k];
            sl[i] = c * __builtin_amdgcn_rcpf(1.f + __expf(-c)); }
        asm volatile("s_waitcnt lgkmcnt(0)" ::: "memory");
        const float* W = p->w_ada + (size_t)l * 1024 * MODW + (size_t)ks * 128 * MODW + col0 + lane;
        float a0 = 0.f, a1 = 0.f, a2 = 0.f, a3 = 0.f, a4 = 0.f;
#pragma unroll 16
        for (int kk = 0; kk < 128; ++kk) { const float w = W[(size_t)kk * MODW];
            a0 += sl[kk] * w; a1 += sl[128 + kk] * w; a2 += sl[256 + kk] * w; a3 += sl[384 + kk] * w; a4 += sl[512 + kk] * w; }
        if (ks == 0) { const float bb = p->b_ada[l * MODW + col0 + lane]; a0 += bb; a1 += bb; a2 += bb; a3 += bb; a4 += bb; }
        float* m = mod + (size_t)(l * 5) * MODW + col0 + lane;
        __hip_atomic_fetch_add(m, a0, __ATOMIC_RELAXED, __HIP_MEMORY_SCOPE_AGENT); __hip_atomic_fetch_add(m + MODW, a1, __ATOMIC_RELAXED, __HIP_MEMORY_SCOPE_AGENT);
        __hip_atomic_fetch_add(m + 2 * MODW, a2, __ATOMIC_RELAXED, __HIP_MEMORY_SCOPE_AGENT); __hip_atomic_fetch_add(m + 3 * MODW, a3, __ATOMIC_RELAXED, __HIP_MEMORY_SCOPE_AGENT);
        __hip_atomic_fetch_add(m + 4 * MODW, a4, __ATOMIC_RELAXED, __HIP_MEMORY_SCOPE_AGENT);
        asm volatile("s_waitcnt lgkmcnt(0)" ::: "memory");
    }
    transposes<1>(kp, lds, gw, NGW, wave, lane);
}

__device__ __forceinline__ void xa_phase(const float* xa, const float* xb, int split, const float* g, const float* scale  , bf16* H, float* rss, int gw, int NGW, int lane_in) {
    const int lane = vopaque(lane_in);
    f32x4 vn[4];
    if (gw < MTOT) { const float* xrow = (gw < split) ? xa + (size_t)gw * D : xb + (size_t)(gw - split) * D; const f32x4* xr = (const f32x4*)xrow + lane;
#pragma unroll
        for (int j = 0; j < 4; ++j) vn[j] = xr[64 * j]; }
    for (int m = gw; m < MTOT; m += NGW) {
        int b = m >> 13; b = b > 4 ? 4 : b;
        f32x4 v[4]; float ss = 0.f;
#pragma unroll
        for (int j = 0; j < 4; ++j) { v[j] = vn[j]; ss += (v[j].x * v[j].x + v[j].y * v[j].y) + (v[j].z * v[j].z + v[j].w * v[j].w); }
        const int mn = m + NGW;
        if (mn < MTOT) { const float* xrow = (mn < split) ? xa + (size_t)mn * D : xb + (size_t)(mn - split) * D; const f32x4* xr = (const f32x4*)xrow + lane;
#pragma unroll
            for (int j = 0; j < 4; ++j) vn[j] = xr[64 * j]; }
        f32x4 gg[4], sc[4];
#pragma unroll
        for (int j = 0; j < 4; ++j) { const int col = 256 * j + 4 * lane; gg[j] = *(const f32x4*)(g + col); sc[j] = *(const f32x4*)(scale + (size_t)b * MODW + col); }
        __builtin_amdgcn_sched_barrier(0);
        ss = wave_sum(ss);
        if (lane == 0) rss[m] = ss;
        u32x2v* o = (u32x2v*)(H + (size_t)m * D) + lane;
#pragma unroll
        for (int j = 0; j < 4; ++j) {
            const f32x4 y = v[j] * gg[j] * (sc[j] + 1.f);
            u32x2v w; w.x = pack2(y.x, y.y); w.y = pack2(y.z, y.w); o[64 * j] = w; }
    }
}
__device__ __forceinline__ void sw_phase(const float* mod, const float* w_in, const float* w_ff1, float* sW, LAS unsigned char* lds, int gw, int NGW, int wave, int lane) {
    LAS float* sl = (LAS float*)(lds + wave * 16384);
    for (int item = gw; item < 1600; item += NGW) {
        const int ks = item & 7, r0 = item >> 3, l = r0 / 100, r = r0 % 100, which = r < 36 ? 0 : 1, cc = which ? r - 36 : r, N = which ? DFF : DIN, col0 = cc * 64;
        const float* sh = mod + (size_t)l * 5 * MODW + (which ? 3 * D : 0) + ks * 128;
        for (int i = lane; i < 640; i += 64) sl[i] = sh[(size_t)(i >> 7) * MODW + (i & 127)];
        asm volatile("s_waitcnt lgkmcnt(0)" ::: "memory");
        const float* W = (which ? w_ff1 + (size_t)l * D * DFF : w_in + (size_t)l * D * DIN) + (size_t)ks * 128 * N + col0 + lane;
        float a0 = 0.f, a1 = 0.f, a2 = 0.f, a3 = 0.f, a4 = 0.f;
#pragma unroll 16
        for (int kk = 0; kk < 128; ++kk) { const float w = W[(size_t)kk * N];
            a0 += sl[kk] * w; a1 += sl[128 + kk] * w; a2 += sl[256 + kk] * w; a3 += sl[384 + kk] * w; a4 += sl[512 + kk] * w; }
        float* o = sW + ((size_t)(l * 2 + which) * 5) * 4096 + col0 + lane;
        __hip_atomic_fetch_add(o, a0, __ATOMIC_RELAXED, __HIP_MEMORY_SCOPE_AGENT); __hip_atomic_fetch_add(o + 4096, a1, __ATOMIC_RELAXED, __HIP_MEMORY_SCOPE_AGENT);
        __hip_atomic_fetch_add(o + 2 * 4096, a2, __ATOMIC_RELAXED, __HIP_MEMORY_SCOPE_AGENT); __hip_atomic_fetch_add(o + 3 * 4096, a3, __ATOMIC_RELAXED, __HIP_MEMORY_SCOPE_AGENT);
        __hip_atomic_fetch_add(o + 4 * 4096, a4, __ATOMIC_RELAXED, __HIP_MEMORY_SCOPE_AGENT);
        asm volatile("s_waitcnt lgkmcnt(0)" ::: "memory");
    }
}

__device__ __forceinline__ int prep_unit(int gidx, int grp) { return gidx == 0 ? 6 + grp : gidx == 1 ? 14 + grp : 24 + (gidx - 2) * 4 + grp; }
__device__ __forceinline__ void prep_task(int task, const bf16* P, bf16* KF, bf16* VF, const float* ka_g, const float* bv_g, const float* kc_g,
                                          const float* ropeC, const float* ropeS, LAS unsigned char* wlds, int lane) {
    const int tb = task / 5, gidx = task % 5;
    const int sub = lane & 15, grp = lane >> 4;
    const int u = prep_unit(gidx, grp);
    const bool isk = (u >= 6 && u < 8) || (u >= 24 && u < 30), isbv = (u >= 14 && u < 18);
    const bool isv = !isk;
    const bf16* base = P + (size_t)tb * 16 * DIN + u * 64 + 4 * sub;
    const float* gp = (u < 8) ? ka_g : kc_g;
    const f32x4 gg = *(const f32x4*)(gp + 4 * sub);
    f32x4 g2 = {1.f, 1.f, 1.f, 1.f};
    if (isbv) g2 = *(const f32x4*)(bv_g + (u - 14) * 64 + 4 * sub);
    const int m0 = tb * 16, pos0 = (m0 < MP) ? (m0 & 8191) : (m0 - MP);
    LAS unsigned char* reg = wlds + grp * 2048;
    const int c = sub >> 1;
    u32x2v rawn[4];
#pragma unroll
    for (int j = 0; j < 4; ++j) rawn[j] = *(const u32x2v*)(base + (size_t)j * DIN);
#pragma unroll 1
    for (int tq4 = 0; tq4 < 4; ++tq4) {
        u32x2v raw[4];
#pragma unroll
        for (int j = 0; j < 4; ++j) raw[j] = rawn[j];
        if (tq4 < 3) {
#pragma unroll
            for (int j = 0; j < 4; ++j) rawn[j] = *(const u32x2v*)(base + (size_t)(4 * tq4 + 4 + j) * DIN);
        }
        float vk[4][4];
#pragma unroll
        for (int j = 0; j < 4; ++j) {
            const int tk = 4 * tq4 + j;
            float x[4] = {bf_lo(raw[j].x), bf_hi(raw[j].x), bf_lo(raw[j].y), bf_hi(raw[j].y)};
            float o[4];
            if (gidx == 1) {
                float sq = sum16((x[0] * x[0] + x[1] * x[1]) + (x[2] * x[2] + x[3] * x[3])); sq += __shfl_xor(sq, 16); sq += __shfl_xor(sq, 32);
                const float r2 = __builtin_amdgcn_rsqf(sq * (1.f / 256.f) + EPS);
                o[0] = x[0] * r2 * g2.x; o[1] = x[1] * r2 * g2.y; o[2] = x[2] * r2 * g2.z; o[3] = x[3] * r2 * g2.w;
            } else if (gidx == 4) {
#pragma unroll
                for (int i = 0; i < 4; ++i) o[i] = x[i];
            } else {
                float ss = sum16((x[0] * x[0] + x[1] * x[1]) + (x[2] * x[2] + x[3] * x[3]));
                const float rinv = __builtin_amdgcn_rsqf(ss * (1.f / 64.f) + EPS);
                float y[4] = {x[0] * rinv * gg.x, x[1] * rinv * gg.y, x[2] * rinv * gg.z, x[3] * rinv * gg.w};
                if (gidx == 0) {
                    float yp[4];
#pragma unroll
                    for (int i = 0; i < 4; ++i) yp[i] = dpp_f<0x4E>(y[i]);
                    if (sub < 4) {
                        const f32x4 c4 = *(const f32x4*)(ropeC + (pos0 + tk) * 8 + 4 * (sub & 1)), s4 = *(const f32x4*)(ropeS + (pos0 + tk) * 8 + 4 * (sub & 1));
                        const float sg = (sub < 2) ? -1.f : 1.f;
                        y[0] = y[0] * c4.x + sg * yp[0] * s4.x; y[1] = y[1] * c4.y + sg * yp[1] * s4.y; y[2] = y[2] * c4.z + sg * yp[2] * s4.z; y[3] = y[3] * c4.w + sg * yp[3] * s4.w;
                    }
                }
#pragma unroll
                for (int i = 0; i < 4; ++i) o[i] = isk ? y[i] : x[i];
            }
            if (isk) { u32x2v w; w.x = pack2(o[0], o[1]); w.y = pack2(o[2], o[3]);
                *(LAS u32x2v*)(reg + (c * 16 + (tk ^ c)) * 16 + (sub & 1) * 8) = w; }
#pragma unroll
            for (int i = 0; i < 4; ++i) vk[j][i] = o[i];
        }
        if (isv) {
#pragma unroll
            for (int i = 0; i < 4; ++i) { const int d = 4 * sub + i;
                u32x2v w; w.x = pack2(vk[0][i], vk[1][i]); w.y = pack2(vk[2][i], vk[3][i]);
                *(LAS u32x2v*)(reg + (((d >> 4) * 4 + tq4) * 16 + (d & 15)) * 8) = w; }
        }
    }
    asm volatile("s_waitcnt lgkmcnt(0)" ::: "memory");
#pragma unroll
    for (int r = 0; r < 4; ++r) {
        const int ur = prep_unit(gidx, r);
        const bool rk = (ur >= 6 && ur < 8) || (ur >= 24 && ur < 30), rv = (ur >= 8 && ur < 10) || (ur >= 14 && ur < 18) || (ur >= 30);
        if (rk) {
            const int kh = (ur < 8) ? (ur - 6) : (ur - 22);
            bf16* dst = KF + ((size_t)tb * 8 + kh) * 1024 + lane * 8;
            const int c0 = lane >> 4, f0 = lane & 15;
            const u32x4v d0 = *(const LAS u32x4v*)(wlds + r * 2048 + (c0 * 16 + (f0 ^ c0)) * 16);
            const u32x4v d1 = *(const LAS u32x4v*)(wlds + r * 2048 + ((c0 + 4) * 16 + (f0 ^ (c0 + 4))) * 16);
            *(u32x4v*)dst = d0; *(u32x4v*)(dst + 512) = d1;
        } else if (rv) {
            const int vh = (ur < 10) ? (ur - 8) : (ur < 18) ? (ur - 12) : (ur - 24);
            bf16* dst = VF + ((size_t)tb * 12 + vh) * 1024 + lane * 8;
            const u32x4v d0 = *(const LAS u32x4v*)(wlds + r * 2048 + lane * 16), d1 = *(const LAS u32x4v*)(wlds + r * 2048 + 1024 + lane * 16);
            *(u32x4v*)dst = d0; *(u32x4v*)(dst + 512) = d1;
        }
    }
    asm volatile("s_waitcnt lgkmcnt(0)" ::: "memory");
}

__device__ __forceinline__ bf16x8 vf_frag(const bf16* p0, const bf16* p1) {
    const u32x2v lo = *(const u32x2v*)p0, hi = *(const u32x2v*)p1;
    u32x4v w; w.x = lo.x; w.y = lo.y; w.z = hi.x; w.w = hi.y; return __builtin_bit_cast(bf16x8, w);
}
__device__ __forceinline__ bf16x8 pack_p(const f32x4& a, const f32x4& b) {
    u32x4v w; w.x = pack2(a.x, a.y); w.y = pack2(a.z, a.w); w.z = pack2(b.x, b.y); w.w = pack2(b.z, b.w); return __builtin_bit_cast(bf16x8, w);
}

__device__ __forceinline__ void dma1k(const bf16* gsrc_lane, LAS unsigned char* ldst) {
    __builtin_amdgcn_global_load_lds((const unsigned*)gsrc_lane, (LAS unsigned*)ldst, 16, 0, 0);
}
__device__ __forceinline__ bf16x8 lds_vfrag(const LAS unsigned char* p0, const LAS unsigned char* p1) {
    const u32x2v lo = *(const LAS u32x2v*)p0, hi = *(const LAS u32x2v*)p1;
    u32x4v w; w.x = lo.x; w.y = lo.y; w.z = hi.x; w.w = hi.y; return __builtin_bit_cast(bf16x8, w);
}

template <bool ROPE> __device__ __forceinline__ void q_prep(bf16x8& q0, bf16x8& q1, const float* g, const float* ropeC, const float* ropeS, int pos, int fq) {
    const u32x4v a = __builtin_bit_cast(u32x4v, q0), b = __builtin_bit_cast(u32x4v, q1);
    float x0[8] = {bf_lo(a.x), bf_hi(a.x), bf_lo(a.y), bf_hi(a.y), bf_lo(a.z), bf_hi(a.z), bf_lo(a.w), bf_hi(a.w)};
    float x1[8] = {bf_lo(b.x), bf_hi(b.x), bf_lo(b.y), bf_hi(b.y), bf_lo(b.z), bf_hi(b.z), bf_lo(b.w), bf_hi(b.w)};
    float ss = 0.f;
#pragma unroll
    for (int j = 0; j < 8; ++j) ss += x0[j] * x0[j] + x1[j] * x1[j];
    ss += __shfl_xor(ss, 16); ss += __shfl_xor(ss, 32);
    const float sc = __builtin_amdgcn_rsqf(ss * (1.f / 64.f) + EPS) * QSCALE;
    const f32x4 g0a = *(const f32x4*)(g + 8 * fq), g0b = *(const f32x4*)(g + 8 * fq + 4), g1a = *(const f32x4*)(g + 32 + 8 * fq), g1b = *(const f32x4*)(g + 36 + 8 * fq);
    const float gv0[8] = {g0a.x, g0a.y, g0a.z, g0a.w, g0b.x, g0b.y, g0b.z, g0b.w}, gv1[8] = {g1a.x, g1a.y, g1a.z, g1a.w, g1b.x, g1b.y, g1b.z, g1b.w};
#pragma unroll
    for (int j = 0; j < 8; ++j) { x0[j] *= sc * gv0[j]; x1[j] *= sc * gv1[j]; }
    if (ROPE) {
        float pr[8];
#pragma unroll
        for (int j = 0; j < 8; ++j) pr[j] = __shfl_xor(x0[j], 16);
        if (fq < 2) {
            const f32x4 ca = *(const f32x4*)(ropeC + pos * 8), cb = *(const f32x4*)(ropeC + pos * 8 + 4), sa = *(const f32x4*)(ropeS + pos * 8), sb = *(const f32x4*)(ropeS + pos * 8 + 4);
            const float cv[8] = {ca.x, ca.y, ca.z, ca.w, cb.x, cb.y, cb.z, cb.w}, sv[8] = {sa.x, sa.y, sa.z, sa.w, sb.x, sb.y, sb.z, sb.w};
            const float sg = (fq == 0) ? -1.f : 1.f;
#pragma unroll
            for (int j = 0; j < 8; ++j) x0[j] = x0[j] * cv[j] + sg * pr[j] * sv[j];
        }
    }
    u32x4v oa, ob;
    oa.x = pack2(x0[0], x0[1]); oa.y = pack2(x0[2], x0[3]); oa.z = pack2(x0[4], x0[5]); oa.w = pack2(x0[6], x0[7]);
    ob.x = pack2(x1[0], x1[1]); ob.y = pack2(x1[2], x1[3]); ob.z = pack2(x1[4], x1[5]); ob.w = pack2(x1[6], x1[7]);
    q0 = __builtin_bit_cast(bf16x8, oa); q1 = __builtin_bit_cast(bf16x8, ob);
}

__device__ __forceinline__ void mixer_b_task(int task, const bf16* P, const bf16* VF, bf16* MIX, const float* w_sp, const float* b_sp, int lane);
__device__ __forceinline__ void mixer_a_item(int idx, const bf16* P, const bf16* KF, const bf16* VF, bf16* MIX, const float* sink, const float* qg, const float* ropeC, LAS unsigned char* lds, int wave, int lane, int btask, const float* w_sp, const float* b_sp) {
    const int blkg = idx >> 1, kvh = idx & 1;
    int n, S, row0;
    if (blkg < 256) { n = blkg & 63; S = 8192; row0 = (blkg >> 6) * 8192; } else { n = blkg - 256; S = 16384; row0 = MP; }
    const int tb0 = (row0 >> 4) + 8 * (n - 1), tblo = row0 >> 4, tbhi = ((row0 + S) >> 4) - 1;
    LAS unsigned char* Kl = lds; LAS unsigned char* Vl = lds + 49152;
#pragma unroll 1
    for (int j = 0; j < 12; ++j) {
        const int i = wave + 8 * j, which = i / 48, rem = i % 48, blk = rem >> 1, half = rem & 1;
        int tb = tb0 + blk; tb = tb < tblo ? tblo : tb; tb = tb > tbhi ? tbhi : tb;
        const bf16* src = which ? VF + ((size_t)tb * 12 + kvh) * 1024 + half * 512 + lane * 8 : KF + ((size_t)tb * 8 + kvh) * 1024 + half * 512 + lane * 8;
        dma1k(src, (which ? Vl : Kl) + blk * 2048 + half * 1024);
    }
    const int fr = lane & 15, fq = lane >> 4;
    const int tq = row0 + 128 * n + 16 * wave;
    bf16x8 qf[3][2];
#pragma unroll
    for (int g = 0; g < 3; ++g) { const bf16* qp = P + (size_t)(tq + fr) * DIN + (kvh * 3 + g) * 64 + 8 * fq; qf[g][0] = *(const bf16x8*)qp; qf[g][1] = *(const bf16x8*)(qp + 32); }
#pragma unroll
    for (int g = 0; g < 3; ++g) q_prep<true>(qf[g][0], qf[g][1], qg, ropeC, ropeC + 16384 * 8, 128 * n + 16 * wave + fr, fq);
    if (btask < 12288) mixer_b_task(btask, P, VF, MIX, w_sp, b_sp, lane);
    asm volatile("s_waitcnt vmcnt(0)" ::: "memory");
    __syncthreads();
#pragma unroll 1
    for (int g = 0; g < 3; ++g) {
        const int head = kvh * 3 + g;
        const bf16x8 q0 = g == 0 ? qf[0][0] : g == 1 ? qf[1][0] : qf[2][0], q1 = g == 0 ? qf[0][1] : g == 1 ? qf[1][1] : qf[2][1];
        f32x4 s[18];
#pragma unroll
        for (int kb = 0; kb < 17; ++kb) {
            int blk = wave + kb; blk = blk > 23 ? 23 : blk;
            const LAS unsigned char* kp = Kl + blk * 2048 + lane * 16;
            const bf16x8 k0 = *(const LAS bf16x8*)kp, k1 = *(const LAS bf16x8*)(kp + 1024);
            f32x4 acc = {0.f, 0.f, 0.f, 0.f};
            acc = mfma16(k0, q0, acc); acc = mfma16(k1, q1, acc); s[kb] = acc;
        }
        const float sk2 = sink[head] * LOG2E;
        float mx = sk2;
#pragma unroll
        for (int kb = 0; kb < 17; ++kb)
#pragma unroll
            for (int i = 0; i < 4; ++i) {
                const int rel = 16 * kb + 4 * fq + i - fr;
                const int kpos = 128 * (n - 1) + (wave + kb) * 16 + 4 * fq + i;
                const bool ok = rel >= 0 && rel <= 256 && kpos >= 0 && kpos < S;
                const float v = ok ? s[kb][i] : -1e30f; s[kb][i] = v; mx = fmaxf(mx, v);
            }
        mx = fmaxf(mx, __shfl_xor(mx, 16)); mx = fmaxf(mx, __shfl_xor(mx, 32));
        float sum = 0.f;
#pragma unroll
        for (int kb = 0; kb < 17; ++kb)
#pragma unroll
            for (int i = 0; i < 4; ++i) { const float pe = __builtin_amdgcn_exp2f(s[kb][i] - mx); s[kb][i] = pe; sum += pe; }
        s[17] = (f32x4){0.f, 0.f, 0.f, 0.f};
        sum += __shfl_xor(sum, 16); sum += __shfl_xor(sum, 32);
        const float inv = 1.f / (sum + __builtin_amdgcn_exp2f(sk2 - mx));
        f32x4 o[4];
#pragma unroll
        for (int db = 0; db < 4; ++db) o[db] = (f32x4){0.f, 0.f, 0.f, 0.f};
#pragma unroll
        for (int pp = 0; pp < 9; ++pp) {
            const bf16x8 pb = pack_p(s[2 * pp], s[2 * pp + 1]);
            int b0 = wave + 2 * pp, b1 = b0 + 1; b0 = b0 > 23 ? 23 : b0; b1 = b1 > 23 ? 23 : b1;
#pragma unroll
            for (int db = 0; db < 4; ++db) o[db] = mfma16(lds_vfrag(Vl + b0 * 2048 + db * 512 + lane * 8, Vl + b1 * 2048 + db * 512 + lane * 8), pb, o[db]);
        }
        bf16* op = MIX + (size_t)(tq + fr) * D + head * 64 + 4 * fq;
#pragma unroll
        for (int db = 0; db < 4; ++db) { const f32x4 v = o[db] * inv; u32x2v wv_; wv_.x = pack2(v.x, v.y); wv_.y = pack2(v.z, v.w); *(u32x2v*)(op + 16 * db) = wv_; }
    }
    __syncthreads();
}

__device__ __forceinline__ void mixer_c_item(int idx, const bf16* P, const bf16* KF, const bf16* VF, bf16* MIX, const float* rel_bias, const float* qg, LAS unsigned char* lds, int tid, int wave, int lane, int btask, const float* w_sp, const float* b_sp) {
    const int rp = idx / 6, h = idx % 6;
    int r0, rows, tok0;
    if (rp < 256) { r0 = 2 * (rp & 63); rows = 128; tok0 = (rp >> 6) * 8192; } else { r0 = 2 * (rp - 256); rows = 256; tok0 = MP; }
    int rs0 = r0 - 4; rs0 = rs0 < 0 ? 0 : rs0; rs0 = rs0 > rows - 8 ? rows - 8 : rs0;
    LAS unsigned char* Kl = lds; LAS unsigned char* Vl = lds + 73728; LAS float* biasL = (LAS float*)(lds + 147456);
#pragma unroll 1
    for (int j = 0; j < 18; ++j) {
        const int i = wave + 8 * j, which = i / 72, rem = i % 72, blk = rem >> 1, half = rem & 1;
        int krow = rs0 + (blk >> 2); krow = krow > rows - 1 ? rows - 1 : krow;
        const int tb = (tok0 >> 4) + krow * 4 + (blk & 3);
        const bf16* src = which ? VF + ((size_t)tb * 12 + 6 + h) * 1024 + half * 512 + lane * 8 : KF + ((size_t)tb * 8 + 2 + h) * 1024 + half * 512 + lane * 8;
        dma1k(src, (which ? Vl : Kl) + blk * 2048 + half * 1024);
    }
    if (tid < 465) biasL[tid] = rel_bias[h * 465 + tid] * LOG2E;
    const int fr = lane & 15, fq = lane >> 4;
    const int r = r0 + (wave >> 2), j = wave & 3;
    int rs = r - 4; rs = rs < 0 ? 0 : rs; rs = rs > rows - 8 ? rows - 8 : rs;
    const int cb0 = j < 2 ? 0 : 1;
    const int qc = 16 * j + fr;
    const int tq = tok0 + r * 64 + 16 * j;
    int cs = qc - 8; cs = cs < 0 ? 0 : cs; cs = cs > 48 ? 48 : cs;
    const bf16* qp = P + (size_t)(tq + fr) * DIN + 1152 + h * 64 + 8 * fq;
    bf16x8 q0 = *(const bf16x8*)qp, q1 = *(const bf16x8*)(qp + 32);
    q_prep<false>(q0, q1, qg, nullptr, nullptr, 0, fq);
    if (btask < 12288) mixer_b_task(btask, P, VF, MIX, w_sp, b_sp, lane);
    asm volatile("s_waitcnt vmcnt(0)" ::: "memory");
    __syncthreads();
    const int lb0 = (rs - rs0) * 4 + cb0;
    f32x4 s[24];
#pragma unroll
    for (int kb = 0; kb < 24; ++kb) {
        const LAS unsigned char* kp = Kl + (lb0 + 4 * (kb / 3) + kb % 3) * 2048 + lane * 16;
        const bf16x8 k0 = *(const LAS bf16x8*)kp, k1 = *(const LAS bf16x8*)(kp + 1024);
        f32x4 acc = {0.f, 0.f, 0.f, 0.f};
        acc = mfma16(k0, q0, acc); acc = mfma16(k1, q1, acc); s[kb] = acc;
    }
    float mx = -1e30f;
#pragma unroll
    for (int kb = 0; kb < 24; ++kb) {
        const int kr = kb / 3, t = kb % 3;
        const int dr = rs + kr - r + 7;
#pragma unroll
        for (int i = 0; i < 4; ++i) {
            const int kc = 16 * (cb0 + t) + 4 * fq + i;
            const bool ok = kc >= cs && kc < cs + 16;
            int dc = kc - qc + 15; dc = dc < 0 ? 0 : dc; dc = dc > 30 ? 30 : dc;
            const float v = ok ? s[kb][i] + biasL[dr * 31 + dc] : -1e30f; s[kb][i] = v; mx = fmaxf(mx, v);
        }
    }
    mx = fmaxf(mx, __shfl_xor(mx, 16)); mx = fmaxf(mx, __shfl_xor(mx, 32));
    float sum = 0.f;
#pragma unroll
    for (int kb = 0; kb < 24; ++kb)
#pragma unroll
        for (int i = 0; i < 4; ++i) { const float pe = __builtin_amdgcn_exp2f(s[kb][i] - mx); s[kb][i] = pe; sum += pe; }
    sum += __shfl_xor(sum, 16); sum += __shfl_xor(sum, 32);
    const float inv = 1.f / sum;
    f32x4 o[4];
#pragma unroll
    for (int db = 0; db < 4; ++db) o[db] = (f32x4){0.f, 0.f, 0.f, 0.f};
#pragma unroll
    for (int pp = 0; pp < 12; ++pp) {
        const bf16x8 pb = pack_p(s[2 * pp], s[2 * pp + 1]);
        const int kb0 = 2 * pp, kb1 = 2 * pp + 1;
        const LAS unsigned char* v0 = Vl + (lb0 + 4 * (kb0 / 3) + kb0 % 3) * 2048 + lane * 8; const LAS unsigned char* v1 = Vl + (lb0 + 4 * (kb1 / 3) + kb1 % 3) * 2048 + lane * 8;
#pragma unroll
        for (int db = 0; db < 4; ++db) o[db] = mfma16(lds_vfrag(v0 + db * 512, v1 + db * 512), pb, o[db]);
    }
    bf16* op = MIX + (size_t)(tq + fr) * D + 640 + h * 64 + 4 * fq;
#pragma unroll
    for (int db = 0; db < 4; ++db) { const f32x4 v = o[db] * inv; u32x2v wv_; wv_.x = pack2(v.x, v.y); wv_.y = pack2(v.z, v.w); *(u32x2v*)(op + 16 * db) = wv_; }
    __syncthreads();
}

__device__ __forceinline__ void mixer_b_task(int task, const bf16* P, const bf16* VF, bf16* MIX, const float* w_sp, const float* b_sp, int lane) {
    const int g = task / 3072, p16 = task % 3072;
    const int fr = lane & 15, fq = lane >> 4;
    const int pt = (p16 & 7) * 16 + fr;
    const int tbc = p16 & ~7;
    const size_t tok = (size_t)p16 * 16 + fr;
    f32x4 wv[4][2];
#pragma unroll
    for (int ks = 0; ks < 4; ++ks) { const float* wp = w_sp + (size_t)(g * 128 + pt) * 128 + 32 * ks + 4 * fq; wv[ks][0] = *(const f32x4*)wp; wv[ks][1] = *(const f32x4*)(wp + 16); }
    const bf16* vfl = VF + ((size_t)tbc * 12 + 2 + g) * 1024 + lane * 4;
    bf16x8 vf[4][4];
#pragma unroll
    for (int ks = 0; ks < 4; ++ks)
#pragma unroll
        for (int eb = 0; eb < 4; ++eb) vf[ks][eb] = vf_frag(vfl + (size_t)(2 * ks) * 12288 + eb * 256, vfl + (size_t)(2 * ks + 1) * 12288 + eb * 256);
    u32x2v uus[4];
#pragma unroll
    for (int eb = 0; eb < 4; ++eb) uus[eb] = *(const u32x2v*)(P + tok * DIN + 640 + g * 64 + 16 * eb + 4 * fq);
    const float bias = b_sp[g * 128 + pt];
    f32x4 d[4];
#pragma unroll
    for (int eb = 0; eb < 4; ++eb) d[eb] = (f32x4){0.f, 0.f, 0.f, 0.f};
#pragma unroll
    for (int ks = 0; ks < 4; ++ks) {
        const bf16x8 bw = pack_p(wv[ks][0], wv[ks][1]);
#pragma unroll
        for (int eb = 0; eb < 4; ++eb) d[eb] = mfma16(vf[ks][eb], bw, d[eb]);
    }
#pragma unroll
    for (int eb = 0; eb < 4; ++eb) {
        const u32x2v uu = uus[eb];
        const float o0 = bf_lo(uu.x) * (d[eb].x + bias), o1 = bf_hi(uu.x) * (d[eb].y + bias), o2 = bf_lo(uu.y) * (d[eb].z + bias), o3 = bf_hi(uu.y) * (d[eb].w + bias);
        u32x2v w; w.x = pack2(o0, o1); w.y = pack2(o2, o3);
        *(u32x2v*)(MIX + tok * D + 384 + g * 64 + 16 * eb + 4 * fq) = w;
    }
}

#define XB_TMO      128
#define XB_XCNT(j)  (256  + 64 * (j))
#define XB_XSUB(j)  (1280 + 64 * (j))
#define XB_XGEN(j)  (2304 + 64 * (j))
#define XB_TOP      3328
#define XB_TOPGEN   3392
#define XCD_BAR_WORDS 3456
#define XB_SPIN_CAP (1u << 18)

__device__ __forceinline__ unsigned xb_ld(unsigned* p)              { return __hip_atomic_load(p, __ATOMIC_RELAXED, __HIP_MEMORY_SCOPE_AGENT); }
__device__ __forceinline__ unsigned xb_add(unsigned* p, unsigned v) { return __hip_atomic_fetch_add(p, v, __ATOMIC_RELAXED, __HIP_MEMORY_SCOPE_AGENT); }
__device__ __forceinline__ unsigned xb_xcc_id() { return (unsigned)__builtin_amdgcn_s_getreg((3 << 11) | 20) & 0xFu; }
#define XB_SPIN(cond, bar) do { unsigned _sp = 0; while (cond) { __builtin_amdgcn_s_sleep(1); \
    if ((++_sp & 255u) == 0u) { if (xb_ld(&(bar)[XB_TMO])) break; if (_sp > XB_SPIN_CAP) { atomicAdd(&(bar)[XB_TMO], 1u); break; } } } } while (0)

struct XcdBarrier {
    unsigned* bar; unsigned x;
    volatile LAS unsigned* st;
};

__device__ __forceinline__ XcdBarrier xcd_barrier_post(unsigned* bar, volatile LAS unsigned* st) {
    XcdBarrier b; b.bar = bar; b.x = xb_xcc_id(); b.st = st;
    if (threadIdx.x == 0) (void)xb_add(&bar[XB_XCNT(b.x)], 1u);
    return b;
}
__device__ __forceinline__ void xcd_barrier_complete(unsigned* bar, unsigned x, unsigned& nloc, unsigned& nx) {
    const unsigned G = gridDim.x * gridDim.y * gridDim.z;
    unsigned sum, cnt, mine, sp = 0u;
    for (;;) {
        sum = 0u; cnt = 0u; mine = 0u;
#pragma unroll
        for (unsigned j = 0; j < 16; ++j) { const unsigned c = xb_ld(&bar[XB_XCNT(j)]); sum += c; cnt += (c > 0u) ? 1u : 0u; mine = (j == x) ? c : mine; }
        if (sum == G) break;
        __builtin_amdgcn_s_sleep(1);
        if ((++sp & 255u) == 0u) { if (xb_ld(&bar[XB_TMO])) break; if (sp > XB_SPIN_CAP) { atomicAdd(&bar[XB_TMO], 1u); break; } }
    }
    nloc = mine > 0u ? mine : 1u; nx = cnt > 0u ? cnt : 1u;
}

__device__ __forceinline__ void xcd_barrier(const XcdBarrier& b) {
    asm volatile("s_waitcnt vmcnt(0)" ::: "memory");
    __syncthreads();
    if (threadIdx.x == 0) {
        unsigned* bar = b.bar;
        __builtin_amdgcn_s_waitcnt(0);
        unsigned nloc = b.st[0], nx = b.st[1];
        if (nloc == 0u) { xcd_barrier_complete(bar, b.x, nloc, nx); b.st[0] = nloc; b.st[1] = nx; }
        const unsigned old = xb_add(&bar[XB_XSUB(b.x)], 1u);
        const unsigned gen = old / nloc;
        if (old + 1u == (gen + 1u) * nloc) {
            __builtin_amdgcn_fence(__ATOMIC_RELEASE, "agent");
            asm volatile("s_waitcnt vmcnt(0)" ::: "memory");
            const unsigned og = xb_add(&bar[XB_TOP], 1u);
            const unsigned tg = og / nx;
            if (og + 1u == (tg + 1u) * nx) xb_add(&bar[XB_TOPGEN], 1u);
            else XB_SPIN(xb_ld(&bar[XB_TOPGEN]) == tg, bar);
            __builtin_amdgcn_fence(__ATOMIC_ACQUIRE, "agent");
            xb_add(&bar[XB_XGEN(b.x)], 1u);
            asm volatile("s_waitcnt vmcnt(0)" ::: "memory");
        } else {
            XB_SPIN(xb_ld(&bar[XB_XGEN(b.x)]) == gen, bar);
            __builtin_amdgcn_fence(__ATOMIC_ACQUIRE, "agent");
            asm volatile("s_waitcnt vmcnt(0)" ::: "memory");
        }
    }
    __syncthreads();
}
__global__ void __launch_bounds__(512, 2) fwd_kernel(Params p_unused) {
    extern __shared__ __attribute__((aligned(16))) unsigned char lds_raw[];
    cg::grid_group grid = cg::this_grid();
    KPtr kp = (KPtr)__builtin_amdgcn_kernarg_segment_ptr();
    LAS unsigned char* lds = (LAS unsigned char*)lds_raw;
    const int wave = __builtin_amdgcn_readfirstlane((int)threadIdx.x >> 6);
#define lane (lane_id_asm())
#define tid (wave * 64 + lane)
#define PH_IDS const int wv = sopaque(wave), bid = sopaque((int)blockIdx.x), G = sopaque((int)gridDim.x), gw = bid * 8 + wv, NGW = G * 8, vcu = (G % 8 == 0) ? (bid % 8) * (G / 8) + bid / 8 : bid, gwx = vcu * 8 + wv; (void)gw; (void)NGW; (void)wv; (void)gwx

    volatile LAS unsigned* bst = (volatile LAS unsigned*)(lds + LDS_BAR_OFF);
    if (tid < 64) bst[tid] = 0u;
    {
        KPtr q = kopaque(kp); unsigned* bw = (unsigned*)(q->ws + WS_BAR);
        if (blockIdx.x == 0) for (int i = tid; i < XCD_BAR_WORDS; i += 512) bw[i] = 0u;
    }
    __syncthreads();
    phase0a(kp, lds, tid, wave, lane);
    grid.sync();
    { KPtr q = kopaque(kp); (void)xcd_barrier_post((unsigned*)(q->ws + WS_BAR), bst); }
#define GRID_BAR() do { XcdBarrier b_; b_.bar = (unsigned*)(kopaque(kp)->ws + WS_BAR); b_.x = xb_xcc_id(); b_.st = (volatile LAS unsigned*)(lds + LDS_BAR_OFF); xcd_barrier(b_); } while (0)
    { PH_IDS; phase0b(kp, lds, gw, NGW, wv, lane); }
    GRID_BAR();

#pragma unroll 1
    for (int l = 0; l < 2; ++l) {
        if (l == 0) {
            PH_IDS; KPtr q = kopaque(kp); unsigned char* ws = q->ws;
            const float* mod = (const float*)(ws + WS_MOD);
            sw_phase(mod, q->w_in, q->w_ff1, (float*)(ws + WS_SW), lds, gw, NGW, wv, lane);
            xa_phase(q->x_prompt, q->x_sample, MP, q->norm1_g, mod + 1 * D, (bf16*)(ws + WS_H), (float*)(ws + WS_RSS), gw, NGW, lane);
            transposes<2>(kp, lds, gw, NGW, wv, lane);
            GRID_BAR();
        }
        {
            PH_IDS; KPtr q = kopaque(kp); unsigned char* ws = q->ws;
            pg8::Gemm g{(const bf16*)(ws + WS_H), (const bf16*)(ws + WS_WIN) + (size_t)l * DIN * D, MTOT, DIN, D}; pg8::StaticOrder S; S.init(MTOT, DIN, G, bid);
            pg8::EpiBf16N<0> E{(bf16*)(ws + WS_PROJ), DIN, (const float*)(ws + WS_RSS) + (size_t)(2 * l) * MTOT, (const float*)(ws + WS_SW) + (size_t)(2 * l) * 5 * 4096, 4096, 0, 640, 1152};
            pg8::gemm_phase<pg8::EpiBf16N<0>, pg8::StaticOrder, true, true>(lds, g, S, E, wv);
        }
        GRID_BAR();
        {
            PH_IDS; KPtr q = kopaque(kp); unsigned char* ws = q->ws;
            const float* ropeC = (const float*)(ws + WS_ROPE);
            bf16* PROJ = (bf16*)(ws + WS_PROJ); bf16* KF = (bf16*)(ws + WS_KF); bf16* VF = (bf16*)(ws + WS_VF);
            const float *ka = q->ka_g + l * 64, *bvg = q->bv_g + l * 256, *kc = q->kc_g + l * 64;
            const int lane_o = vopaque(tid) & 63;
#pragma unroll 1
            for (int task = gwx; task < 15360; task += NGW) prep_task(task, PROJ, KF, VF, ka, bvg, kc, ropeC, ropeC + 16384 * 8, lds + wv * 8192, lane_o);
            __syncthreads();
        }
        GRID_BAR();
        {
        {
            PH_IDS; KPtr q = kopaque(kp); unsigned char* ws = q->ws;
            const bf16* PROJ = (const bf16*)(ws + WS_PROJ); const bf16* KF = (const bf16*)(ws + WS_KF); const bf16* VF = (const bf16*)(ws + WS_VF); bf16* MIXB = (bf16*)(ws + WS_MIX);
            const float* sink = q->a_sink + l * 6; const float* wsp = q->w_sp + (size_t)l * 4 * 128 * 128; const float* bsp = q->b_sp + l * 4 * 128; const float* rb = q->rel_bias + l * 6 * 465;
            const int tid_o = vopaque(tid), lane_o = tid_o & 63;
            int btask = gwx;
#pragma unroll 1
            for (int it = vcu; it < 2304; it += G) { mixer_c_item(it, PROJ, KF, VF, MIXB, rb, q->qc_g + l * 64, lds, tid_o, wv, lane_o, btask, wsp, bsp); btask += NGW; }
#pragma unroll 1
            for (int it = vcu; it < 768; it += G) { mixer_a_item(it, PROJ, KF, VF, MIXB, sink, q->qa_g + l * 64, (const float*)(ws + WS_ROPE), lds, wv, lane_o, btask, wsp, bsp); btask += NGW; }
#pragma unroll 1
            for (; btask < 12288; btask += NGW) mixer_b_task(btask, PROJ, VF, MIXB, wsp, bsp, lane_o);
            __syncthreads();
        }
        }
        GRID_BAR();
        {
            PH_IDS; KPtr q = kopaque(kp); unsigned char* ws = q->ws; float* out = q->out;
            const float* mod_l = (const float*)(ws + WS_MOD) + (size_t)l * 5 * MODW;
            const float* xa = (l == 0) ? q->x_prompt : out; const float* xb = (l == 0) ? q->x_sample : out; const int split = (l == 0) ? MP : (1 << 30);
            pg8::Gemm g{(const bf16*)(ws + WS_MIX), (const bf16*)(ws + WS_WOUT) + (size_t)l * D * D, MTOT, D, D}; pg8::StaticOrder S; S.init(MTOT, D, G, bid);
            if (l == 0) {
                pg8::EpiResGateN<false, true> E{xa, xb, split, nullptr, nullptr, (bf16*)(ws + WS_X1B), mod_l + 2 * D, MODW, 0, (bf16*)(ws + WS_H), q->norm2_g + l * D, mod_l + 4 * D, (float*)(ws + WS_RSS) + (size_t)(2 * l + 1) * MTOT, 1};
                pg8::gemm_phase<pg8::EpiResGateN<false, true>, pg8::StaticOrder, true, true>(lds, g, S, E, wv);
            } else {
                pg8::EpiResGateN<true, true> E{nullptr, nullptr, 0, (const bf16*)out, nullptr, (bf16*)(ws + WS_X1B), mod_l + 2 * D, MODW, 0, (bf16*)(ws + WS_H), q->norm2_g + l * D, mod_l + 4 * D, (float*)(ws + WS_RSS) + (size_t)(2 * l + 1) * MTOT, 1};
                pg8::gemm_phase<pg8::EpiResGateN<true, true>, pg8::StaticOrder, true, true>(lds, g, S, E, wv);
            }
        }
        GRID_BAR();
#pragma unroll 1
        for (int ph = 0; ph <= NCHUNK; ++ph) {
#pragma unroll 1
            for (int step = 0; step < 2; ++step) {
            const bool swp = (sopaque((int)blockIdx.x) >> 3) & 1;
            const bool do1 = (step == 0) != swp;
            if (do1 && ph < NCHUNK) {
                const int c = ph;
                PH_IDS; KPtr q = kopaque(kp); unsigned char* ws = q->ws;
                pg8::Gemm g{(const bf16*)(ws + WS_H) + (size_t)c * CHUNK_ROWS * D, (const bf16*)(ws + WS_WFF1) + (size_t)l * DFF * D, CHUNK_ROWS, DFF, D}; pg8::StaticOrder S; S.init(CHUNK_ROWS, DFF, G, bid);
                pg8::EpiBf16N<2> E{(bf16*)(ws + WS_FFH + (size_t)(c & 1) * FFH_BYTES), DFF, (const float*)(ws + WS_RSS) + (size_t)(2 * l + 1) * MTOT, (const float*)(ws + WS_SW) + (size_t)(2 * l + 1) * 5 * 4096, 4096, c * CHUNK_ROWS, 0, 0};
                pg8::gemm_phase<pg8::EpiBf16N<2>, pg8::StaticOrder, true, true>(lds, g, S, E, wv);
            }
            if (!do1 && ph > 0) {
                const int c = ph - 1;
                PH_IDS; KPtr q = kopaque(kp); unsigned char* ws = q->ws; float* out = q->out;
                const float* mod_l = (const float*)(ws + WS_MOD) + (size_t)l * 5 * MODW;
                pg8::Gemm g{(const bf16*)(ws + WS_FFH + (size_t)(c & 1) * FFH_BYTES), (const bf16*)(ws + WS_WFF2) + (size_t)l * D * DFF, CHUNK_ROWS, D, DFF}; pg8::StaticOrder S; S.init(CHUNK_ROWS, D, G, bid);
                const float* mod_n = (const float*)(ws + WS_MOD) + (size_t)1 * 5 * MODW;
                if (l == 0) {
                    pg8::EpiResGateN<true, true> E{nullptr, nullptr, 0, (const bf16*)(ws + WS_X1B), nullptr, (bf16*)out, mod_l + 5 * D, MODW, c * CHUNK_ROWS, (bf16*)(ws + WS_H), q->norm1_g + 1 * D, mod_n + 1 * D, (float*)(ws + WS_RSS) + (size_t)2 * MTOT, 1};
                    pg8::gemm_phase<pg8::EpiResGateN<true, true>, pg8::StaticOrder, true, true>(lds, g, S, E, wv);
                } else {
                    pg8::EpiResGateN<true, false> E{nullptr, nullptr, 0, (const bf16*)(ws + WS_X1B), out, nullptr, mod_l + 5 * D, MODW, c * CHUNK_ROWS, (bf16*)(ws + WS_H), q->norm1_g + 1 * D, mod_n + 1 * D, (float*)(ws + WS_RSS) + (size_t)2 * MTOT, 0};
                    pg8::gemm_phase<pg8::EpiResGateN<true, false>, pg8::StaticOrder, true, true>(lds, g, S, E, wv);
                }
            }
            }
            if (!(l == 1 && ph == NCHUNK)) GRID_BAR();
        }
    }
#undef lane
#undef tid
}

extern "C" void kernel_launch(void* const* d_in, const int* in_sizes, int n_in, void* d_out, int out_size, void* d_ws, size_t ws_size, hipStream_t stream) {
    static int grid_blocks = 0;
    if (grid_blocks == 0) {
        if (n_in != 21 || ws_size < WS_END) { fprintf(stderr, "kernel_launch: unexpected n_in %d / ws_size %zu\n", n_in, ws_size); grid_blocks = -1; return; }
        int dev = 0, cus = 0, per_cu = 0;
        hipGetDevice(&dev);
        hipDeviceGetAttribute(&cus, hipDeviceAttributeMultiprocessorCount, dev);
        hipFuncSetAttribute((const void*)fwd_kernel, hipFuncAttributeMaxDynamicSharedMemorySize, LDS_BYTES);
        hipOccupancyMaxActiveBlocksPerMultiprocessor(&per_cu, (const void*)fwd_kernel, 512, LDS_BYTES);
        if (per_cu < 1) per_cu = 1;
        grid_blocks = cus * per_cu;
        (void)hipGetLastError();
    }
    if (grid_blocks < 0) return;
    Params p{};
    const float** pp = (const float**)&p;
    for (int i = 0; i < 21; ++i) pp[i] = (const float*)d_in[i];
    p.out = (float*)d_out; p.ws = (unsigned char*)d_ws;
    void* args[] = {&p};
    hipError_t e = hipLaunchCooperativeKernel((const void*)fwd_kernel, dim3(grid_blocks), dim3(512), args, LDS_BYTES, stream);
    if (e != hipSuccess) fprintf(stderr, "cooperative launch failed: %s (grid %d)\n", hipGetErrorString(e), grid_blocks);
}
```

```cpp
#include <hip/hip_runtime.h>
#include <hip/hip_cooperative_groups.h>
#include <cstdio>
#include <cstdint>
namespace cg = cooperative_groups;
__device__ __forceinline__ int lane_id_asm() { int l; asm volatile("v_mbcnt_lo_u32_b32 %0, -1, 0\n\tv_mbcnt_hi_u32_b32 %0, -1, %0" : "=v"(l)); return l; }
namespace pg8 {
#define PG8_LAS __attribute__((address_space(3)))
typedef unsigned short bf16_t;
typedef short bf16x8 __attribute__((ext_vector_type(8)));
typedef float f32x4 __attribute__((ext_vector_type(4)));
typedef unsigned u32x4 __attribute__((ext_vector_type(4)));
constexpr int BM = 256, BK = 64, HALF = 128, HTB = HALF * BK * 2  , STAGE_BYTES = 8 * HTB, NXCD = 8, WGM = 8;

__host__ __device__ __forceinline__ int lds_byte(int r, int c) { const int st = (r >> 4) * 2 + (c >> 5), rr = r & 15, cc = c & 31, ob = rr * 64 + cc * 2; return st * 1024 + (ob ^ (((ob >> 9) & 1) << 5)); }
__host__ __device__ __forceinline__ void stage_rc(int b, int& R, int& C) { const int st = b / 1024, sb = b % 1024, swz = sb ^ (((sb >> 9) & 1) << 5); R = (st >> 1) * 16 + swz / 64; C = (st & 1) * 32 + (swz % 64) / 2; }
__host__ __device__ __forceinline__ int perm32(int rho) { const int n = rho >> 4, i = rho & 15; return 8 * (i >> 2) + 4 * n + (i & 3); }

struct Unit { int pm, pn; };
struct Gemm { const bf16_t* A; const bf16_t* Bt; int M, N, K; };

struct StaticOrder {
    int nM, nN, nwg, G, c;
    __host__ __device__ void init(int M, int N, int G_, int c_) { nM = M / BM; nN = N / BM; nwg = nM * nN; G = G_; c = c_; }
    __host__ __device__ bool next(int i, Unit& u) const {
        const long L = (long)i * G + c; if (L >= nwg) return false;
        int wgid = (int)L; { const int q = nwg / NXCD, r = nwg % NXCD, xcd = wgid % NXCD, off = wgid / NXCD; wgid = (xcd < r ? xcd * (q + 1) : r * (q + 1) + (xcd - r) * q) + off; }
        const int nig = WGM * nN, gid = wgid / nig, fm = gid * WGM, gsz = (nM - fm) < WGM ? (nM - fm) : WGM;
        u.pm = fm + ((wgid % nig) % gsz); u.pn = (wgid % nig) / gsz; return true;
    }
    __device__ __forceinline__ void a_ready(const Unit&) const {}
    __device__ __forceinline__ void done(const Unit&) const {}
};

__device__ __forceinline__ unsigned cvt_pk_bf16(float lo, float hi) { unsigned r; asm volatile("v_cvt_pk_bf16_f32 %0, %1, %2" : "=v"(r) : "v"(lo), "v"(hi)); return r; }
template <int ACT  > struct EpiBf16 {
    static constexpr bool PERM = true, AFTER_DRAIN = false;
    bf16_t* O; int ldc;
    __device__ __forceinline__ void operator()(const f32x4 (&acc)[2][2][4][2], const Unit& u, int wr, int wc, int fr, int fq) const {
        const int row0 = u.pm * BM + wr * 64 + fr; const int col0 = u.pn * BM + wc * 32 + 8 * fq;
#pragma unroll
        for (int ai = 0; ai < 2; ++ai)
#pragma unroll
            for (int m = 0; m < 4; ++m) { bf16_t* rowp = O + (size_t)(row0 + ai * HALF + m * 16) * ldc + col0;
#pragma unroll
                for (int bj = 0; bj < 2; ++bj) { f32x4 v0 = acc[ai][bj][m][0], v1 = acc[ai][bj][m][1];
                    if (ACT == 2) {
#pragma unroll
                        for (int e = 0; e < 4; ++e) { const float a = fmaxf(v0[e], 0.f), b = fmaxf(v1[e], 0.f); v0[e] = a * a; v1[e] = b * b; } }
                    u32x4 w; w.x = cvt_pk_bf16(v0[0], v0[1]); w.y = cvt_pk_bf16(v0[2], v0[3]); w.z = cvt_pk_bf16(v1[0], v1[1]); w.w = cvt_pk_bf16(v1[2], v1[3]);
                    *(u32x4*)(rowp + bj * HALF) = w; } }
    }
};
struct EpiResGate {
    static constexpr bool PERM = false, AFTER_DRAIN = false;
    const float* baseA; const float* baseB; int split; float* out; const float* gate; int gate_stride; int row_off;
    __device__ __forceinline__ void operator()(const f32x4 (&acc)[2][2][4][2], const Unit& u, int wr, int wc, int fr, int fq) const {
        const int R0 = row_off + u.pm * BM; int b = R0 >> 13; b = b > 4 ? 4 : b;
        const float* g = gate + (size_t)b * gate_stride;
        const float* base = (R0 < split) ? baseA + (size_t)R0 * 1024 : baseB + (size_t)(R0 - split) * 1024;
        float* o = out + (size_t)R0 * 1024;
        const int col0 = u.pn * BM + wc * 32 + 4 * fq;
        f32x4 gv[2][2];
#pragma unroll
        for (int bj = 0; bj < 2; ++bj)
#pragma unroll
            for (int n = 0; n < 2; ++n) gv[bj][n] = *(const f32x4*)(g + col0 + bj * HALF + n * 16);
#pragma unroll
        for (int ai = 0; ai < 2; ++ai)
#pragma unroll
            for (int m = 0; m < 4; ++m) { const size_t off = (size_t)(ai * HALF + wr * 64 + m * 16 + fr) * 1024 + col0;
#pragma unroll
                for (int bj = 0; bj < 2; ++bj)
#pragma unroll
                    for (int n = 0; n < 2; ++n) { const f32x4 bs = *(const f32x4*)(base + off + bj * HALF + n * 16);
                        *(f32x4*)(o + off + bj * HALF + n * 16) = bs + gv[bj][n] * acc[ai][bj][m][n]; } }
    }
};

__device__ __forceinline__ float gelu_t(float x) { const float u = 0.7978845608028654f * (x + 0.044715f * x * x * x); return x * __builtin_amdgcn_rcpf(1.f + __builtin_amdgcn_exp2f(-2.8853900817779268f * u)); }
template <int ACT  > struct EpiBf16N {
    static constexpr bool PERM = true, AFTER_DRAIN = false;
    bf16_t* O; int ldc; const float* rowss; const float* bias; int ldb; int row_off; int gelu_lo, gelu_hi;
    __device__ __forceinline__ void operator()(const f32x4 (&acc)[2][2][4][2], const Unit& u, int wr, int wc, int fr, int fq) const {
        int zz = 0; asm volatile("" : "+v"(zz));
        const int R0 = row_off + u.pm * BM; int b = R0 >> 13; b = b > 4 ? 4 : b;
        const int lrow0 = u.pm * BM + wr * 64 + fr + zz; const int col0 = u.pn * BM + wc * 32 + 8 * fq + zz;
        const float* rss0_ = rowss; bf16_t* O0_ = O; const float* bias0_ = bias; asm volatile("" : "+s"(rss0_), "+s"(O0_), "+s"(bias0_));
        typedef __attribute__((address_space(1))) const float gcf; typedef __attribute__((address_space(1))) bf16_t gbf;
        gcf* rss_ = (gcf*)rss0_; gbf* O_ = (gbf*)O0_; gcf* bias_ = (gcf*)bias0_;
        gcf* bp = bias_ + (size_t)b * ldb + col0;
        f32x4 bv[2][2];
#pragma unroll
        for (int bj = 0; bj < 2; ++bj)
#pragma unroll
            for (int n = 0; n < 2; ++n) bv[bj][n] = *(const __attribute__((address_space(1))) f32x4*)(bp + bj * HALF + 4 * n);
        float rinvs[2][4];
#pragma unroll
        for (int ai = 0; ai < 2; ++ai)
#pragma unroll
            for (int m = 0; m < 4; ++m) rinvs[ai][m] = rss_[row_off + lrow0 + ai * HALF + m * 16];
#pragma unroll
        for (int ai = 0; ai < 2; ++ai)
#pragma unroll
            for (int m = 0; m < 4; ++m) { const int lr = lrow0 + ai * HALF + m * 16; gbf* rowp = O_ + (size_t)lr * ldc + col0;
                const float rinv = rsqrtf(rinvs[ai][m] * (1.f / 1024.f) + 1e-6f);
#pragma unroll
                for (int bj = 0; bj < 2; ++bj) { f32x4 v0 = acc[ai][bj][m][0] * rinv + bv[bj][0], v1 = acc[ai][bj][m][1] * rinv + bv[bj][1];
                    if (ACT == 2) {
#pragma unroll
                        for (int e = 0; e < 4; ++e) { const float a = fmaxf(v0[e], 0.f), b2 = fmaxf(v1[e], 0.f); v0[e] = a * a; v1[e] = b2 * b2; } }
                    if (ACT == 0) { const int cb = u.pn * BM + bj * HALF; if (cb >= gelu_lo && cb < gelu_hi) {
#pragma unroll
                        for (int e = 0; e < 4; ++e) { v0[e] = gelu_t(v0[e]); v1[e] = gelu_t(v1[e]); } } }
                    u32x4 w; w.x = cvt_pk_bf16(v0[0], v0[1]); w.y = cvt_pk_bf16(v0[2], v0[3]); w.z = cvt_pk_bf16(v1[0], v1[1]); w.w = cvt_pk_bf16(v1[2], v1[3]);
                    *(__attribute__((address_space(1))) u32x4*)(rowp + bj * HALF) = w; } }
    }
};
template <bool BASE_BF16  , bool OUT_BF16  > struct EpiResGateN {
    static constexpr bool PERM = true, AFTER_DRAIN = false;
    const float* baseA; const float* baseB; int split; const bf16_t* baseH; float* out; bf16_t* outH; const float* gate; int gate_stride; int row_off;
    bf16_t* XA; const float* ag; const float* ascale; float* rss; int do_next;
    __device__ __forceinline__ void operator()(const f32x4 (&acc)[2][2][4][2], const Unit& u, int wr, int wc, int fr, int fq) const {
        const int R0 = row_off + u.pm * BM; int b = R0 >> 13; b = b > 4 ? 4 : b;
        const float* g = gate + (size_t)b * gate_stride;
        const float* base = BASE_BF16 ? (const float*)nullptr : ((R0 < split) ? baseA + (size_t)R0 * 1024 : baseB + (size_t)(R0 - split) * 1024);
        const bf16_t* baseh = BASE_BF16 ? baseH + (size_t)R0 * 1024 : (const bf16_t*)nullptr;
        float* o = OUT_BF16 ? (float*)nullptr : out + (size_t)R0 * 1024; bf16_t* oh = OUT_BF16 ? outH + (size_t)R0 * 1024 : (bf16_t*)nullptr;
        bf16_t* xa_ = XA + (size_t)R0 * 1024; float* rss_ = rss + R0;
        asm volatile("" : "+s"(g), "+s"(base), "+s"(baseh), "+s"(o), "+s"(oh), "+s"(xa_), "+s"(rss_));
        typedef __attribute__((address_space(1))) const f32x4 gcv4; typedef __attribute__((address_space(1))) f32x4 gv4; typedef __attribute__((address_space(1))) const u32x4 gcu4; typedef __attribute__((address_space(1))) u32x4 gu4;
        const __attribute__((address_space(1))) float* gg_ = (const __attribute__((address_space(1))) float*)g; const __attribute__((address_space(1))) float* gbase = (const __attribute__((address_space(1))) float*)base;
        const __attribute__((address_space(1))) bf16_t* gbaseh = (const __attribute__((address_space(1))) bf16_t*)baseh;
        __attribute__((address_space(1))) float* go = (__attribute__((address_space(1))) float*)o; __attribute__((address_space(1))) bf16_t* goh = (__attribute__((address_space(1))) bf16_t*)oh;
        __attribute__((address_space(1))) bf16_t* gxa = (__attribute__((address_space(1))) bf16_t*)xa_; __attribute__((address_space(1))) float* grss = (__attribute__((address_space(1))) float*)rss_;
        const __attribute__((address_space(1))) float* gag = (const __attribute__((address_space(1))) float*)ag; const __attribute__((address_space(1))) float* gasc = (const __attribute__((address_space(1))) float*)ascale;
        int zz = 0; asm volatile("" : "+v"(zz));
        const int col0 = u.pn * BM + wc * 32 + 8 * fq + zz;
        f32x4 gv[2][2], av[2][2];
#pragma unroll
        for (int bj = 0; bj < 2; ++bj)
#pragma unroll
            for (int n = 0; n < 2; ++n) { gv[bj][n] = *(gcv4*)(gg_ + col0 + bj * HALF + n * 4);
                if (do_next) av[bj][n] = *(gcv4*)(gag + col0 + bj * HALF + n * 4) * (*(gcv4*)(gasc + (size_t)b * gate_stride + col0 + bj * HALF + n * 4) + 1.f);
                else av[bj][n] = (f32x4){0.f, 0.f, 0.f, 0.f}; }
        constexpr int RGS = BASE_BF16 ? 2 : 1, NST = 8 / RGS;
        f32x4 bs[2][RGS][2][2]; u32x4 bsh[2][RGS][2];
        const unsigned rc0 = (unsigned)(wr * 64 + fr + zz) * 1024u + (unsigned)col0;
#define RG_LOAD(st, buf) do { _Pragma("unroll") for (int gi = 0; gi < RGS; ++gi) { const int rg_ = (st) * RGS + gi; const unsigned off_ = rc0 + (unsigned)((rg_ >> 2) * HALF + (rg_ & 3) * 16) * 1024u; \
        if (BASE_BF16) { _Pragma("unroll") for (int bj = 0; bj < 2; ++bj) bsh[buf][gi][bj] = *(gcu4*)(gbaseh + off_ + bj * HALF); } \
        else { _Pragma("unroll") for (int bj = 0; bj < 2; ++bj) _Pragma("unroll") for (int n = 0; n < 2; ++n) bs[buf][gi][bj][n] = *(gcv4*)(gbase + off_ + bj * HALF + n * 4); } } } while (0)
        RG_LOAD(0, 0);
#pragma unroll
        for (int st = 0; st < NST; ++st) {
            if (st + 1 < NST) RG_LOAD(st + 1, (st + 1) & 1);
            __builtin_amdgcn_sched_barrier(0);
#pragma unroll
            for (int gi = 0; gi < RGS; ++gi) {
            const int rg = st * RGS + gi, ai = rg >> 2, m = rg & 3;
            const int r = ai * HALF + wr * 64 + m * 16 + fr; const unsigned off = rc0 + (unsigned)(ai * HALF + m * 16) * 1024u; float ssq = 0.f;
#pragma unroll
            for (int bj = 0; bj < 2; ++bj) { f32x4 x[2];
                if (BASE_BF16) { const u32x4 h = bsh[st & 1][gi][bj];
                    const f32x4 b0 = {__uint_as_float(h.x << 16), __uint_as_float(h.x & 0xffff0000u), __uint_as_float(h.y << 16), __uint_as_float(h.y & 0xffff0000u)};
                    const f32x4 b1 = {__uint_as_float(h.z << 16), __uint_as_float(h.z & 0xffff0000u), __uint_as_float(h.w << 16), __uint_as_float(h.w & 0xffff0000u)};
                    x[0] = b0 + gv[bj][0] * acc[ai][bj][m][0]; x[1] = b1 + gv[bj][1] * acc[ai][bj][m][1];
                } else {
#pragma unroll
                    for (int n = 0; n < 2; ++n) x[n] = bs[st & 1][gi][bj][n] + gv[bj][n] * acc[ai][bj][m][n];
                }
                if (OUT_BF16) { u32x4 w; w.x = cvt_pk_bf16(x[0][0], x[0][1]); w.y = cvt_pk_bf16(x[0][2], x[0][3]); w.z = cvt_pk_bf16(x[1][0], x[1][1]); w.w = cvt_pk_bf16(x[1][2], x[1][3]);
                    *(gu4*)(goh + off + bj * HALF) = w;
                } else {
#pragma unroll
                    for (int n = 0; n < 2; ++n) *(gv4*)(go + off + bj * HALF + n * 4) = x[n];
                }
                if (do_next) { ssq += ((x[0][0] * x[0][0] + x[0][1] * x[0][1]) + (x[0][2] * x[0][2] + x[0][3] * x[0][3])) + ((x[1][0] * x[1][0] + x[1][1] * x[1][1]) + (x[1][2] * x[1][2] + x[1][3] * x[1][3]));
                    const f32x4 y0 = x[0] * av[bj][0], y1 = x[1] * av[bj][1];
                    u32x4 w; w.x = cvt_pk_bf16(y0[0], y0[1]); w.y = cvt_pk_bf16(y0[2], y0[3]); w.z = cvt_pk_bf16(y1[0], y1[1]); w.w = cvt_pk_bf16(y1[2], y1[3]);
                    *(gu4*)(gxa + off + bj * HALF) = w; } }
            if (do_next) { ssq += __shfl_xor(ssq, 16); ssq += __shfl_xor(ssq, 32);
                if (fq == 0) __hip_atomic_fetch_add((float*)(grss + r), ssq, __ATOMIC_RELAXED, __HIP_MEMORY_SCOPE_AGENT); }
            }
            __builtin_amdgcn_sched_barrier(0);
        }
#undef RG_LOAD
    }
};
template <class Epi, class Sched, bool ALIGN_EPI = false, bool SP2 = false>
__device__ __forceinline__ void gemm_phase(PG8_LAS unsigned char* lds, const Gemm g, const Sched& S, const Epi& E, int wave_in) {
    int tid_ = wave_in * 64 + ::lane_id_asm();
    const int tid = tid_, wid = __builtin_amdgcn_readfirstlane(tid >> 6), lane = tid & 63, wr = wid >> 2, wc = wid & 3, fr = lane & 15, fq = lane >> 4;
    const int K = g.K, nt = K / BK;
    unsigned voffA[2], voffB[2];
#pragma unroll
    for (int i = 0; i < 2; ++i) { int R, C; stage_rc(tid * 16 + i * 8192, R, C); const int Rb = Epi::PERM ? ((R & ~31) + perm32(R & 31)) : R;
        voffA[i] = (unsigned)(R * K + C) * 2u; voffB[i] = (unsigned)(Rb * K + C) * 2u; }
    const size_t kstep = (size_t)(BK * 2);
    const size_t hstep = (size_t)HALF * K * 2;
    const size_t tstep = 2 * hstep;
    const unsigned ldsw = (unsigned)wid * 1024u;
    const int aoff = lds_byte(wr * 64 + fr, fq * 8), boff = lds_byte(wc * 32 + fr, fq * 8);
#define PG8_SA(b, h) (((b) * 2 + (h)) * HTB)
#define PG8_SB(b, h) ((4 + (b) * 2 + (h)) * HTB)
#define PG8_STAGE(bufoff, gbase, voff) do { _Pragma("unroll") for (int _i = 0; _i < 2; ++_i) \
        __builtin_amdgcn_global_load_lds((const unsigned*)((const char*)(gbase) + (voff)[_i]), (PG8_LAS unsigned*)(lds + (bufoff) + ldsw + _i * 8192), 16, 0, 0); } while (0)
#define PG8_LDA(dst, b, h) do { _Pragma("unroll") for (int m = 0; m < 4; ++m) _Pragma("unroll") for (int k = 0; k < 2; ++k) dst[m][k] = *(const PG8_LAS bf16x8*)(lds + PG8_SA(b, h) + aoff + m * 2048 + k * 1024); } while (0)
#define PG8_LDB(dst, b, h) do { _Pragma("unroll") for (int n = 0; n < 2; ++n) _Pragma("unroll") for (int k = 0; k < 2; ++k) dst[n][k] = *(const PG8_LAS bf16x8*)(lds + PG8_SB(b, h) + boff + n * 2048 + k * 1024); } while (0)
#define PG8_MMA(ai, bj, At, Bt) do { __builtin_amdgcn_s_setprio(1); _Pragma("unroll") for (int m = 0; m < 4; ++m) _Pragma("unroll") for (int n = 0; n < 2; ++n) _Pragma("unroll") for (int k = 0; k < 2; ++k) \
        acc[ai][bj][m][n] = __builtin_amdgcn_mfma_f32_16x16x32_bf16(Bt[n][k], At[m][k], acc[ai][bj][m][n], 0, 0, 0); __builtin_amdgcn_s_setprio(0); } while (0)
#define PG8_WAIT_V(n) asm volatile("s_waitcnt vmcnt(" #n ")" ::: "memory")
#define PG8_WAIT_L(n) asm volatile("s_waitcnt lgkmcnt(" #n ")" ::: "memory")
#define PG8_BAR __builtin_amdgcn_s_barrier()
#define PG8_SCHED __builtin_amdgcn_sched_barrier(0)
    Unit cur, nxt; int ui = 0;
    if (!S.next(0, cur)) return;
    f32x4 acc[2][2][4][2];
#pragma unroll
    for (int a = 0; a < 2; ++a)
#pragma unroll
        for (int b = 0; b < 2; ++b)
#pragma unroll
            for (int m = 0; m < 4; ++m)
#pragma unroll
                for (int n = 0; n < 2; ++n) acc[a][b][m][n] = (f32x4){0.f, 0.f, 0.f, 0.f};
    bf16x8 At[4][2], B0[2][2], B1[2][2];
    const char* cA = (const char*)g.A + (size_t)cur.pm * tstep; const char* cB = (const char*)g.Bt + (size_t)cur.pn * tstep;
    S.a_ready(cur);
    if constexpr (SP2) {
        PG8_STAGE(PG8_SB(0, 0), cB, voffB); PG8_STAGE(PG8_SB(0, 1), cB + hstep, voffB); PG8_STAGE(PG8_SA(0, 0), cA, voffA); PG8_STAGE(PG8_SA(0, 1), cA + hstep, voffA);
        if (wr == 1) PG8_BAR;
        PG8_WAIT_V(2); PG8_BAR;
        PG8_STAGE(PG8_SB(1, 0), cB + kstep, voffB); PG8_STAGE(PG8_SA(1, 0), cA + kstep, voffA); PG8_STAGE(PG8_SB(1, 1), cB + hstep + kstep, voffB);
        PG8_WAIT_V(6); PG8_BAR;
    } else {
        PG8_STAGE(PG8_SB(0, 0), cB, voffB); PG8_STAGE(PG8_SA(0, 0), cA, voffA); PG8_STAGE(PG8_SB(0, 1), cB + hstep, voffB); PG8_STAGE(PG8_SA(0, 1), cA + hstep, voffA);
        if (wr == 1) PG8_BAR;
        PG8_WAIT_V(4); PG8_BAR;
        PG8_STAGE(PG8_SB(1, 0), cB + kstep, voffB); PG8_STAGE(PG8_SA(1, 0), cA + kstep, voffA); PG8_STAGE(PG8_SB(1, 1), cB + hstep + kstep, voffB);
        PG8_WAIT_V(6); PG8_BAR;
    }
    for (;;) {
        const bool has_next = S.next(ui + 1, nxt);
        const char* nA = has_next ? (const char*)g.A + (size_t)nxt.pm * tstep : cA; const char* nB = has_next ? (const char*)g.Bt + (size_t)nxt.pn * tstep : cB;
        for (int t = 0; t < nt; t += 2) {
            const bool last = (t == nt - 2);
            const char* a1 = cA + (size_t)(t + 1) * kstep;
            const char* a2 = last ? nA : cA + (size_t)(t + 2) * kstep; const char* b2 = last ? nB : cB + (size_t)(t + 2) * kstep;
            const char* a3 = a2 + kstep; const char* b3 = b2 + kstep;
            if (last && has_next) S.a_ready(nxt);
            if constexpr (SP2) {
            PG8_LDB(B0, 0, 0); PG8_LDB(B1, 0, 1); PG8_SCHED; PG8_LDA(At, 0, 0); PG8_STAGE(PG8_SA(1, 1), a1 + hstep, voffA);
            PG8_WAIT_V(8); PG8_WAIT_L(0); PG8_BAR; PG8_MMA(0, 0, At, B0); PG8_MMA(0, 1, At, B1); PG8_BAR; PG8_SCHED;
            PG8_LDA(At, 0, 1); PG8_STAGE(PG8_SB(0, 0), b2, voffB); PG8_STAGE(PG8_SB(0, 1), b2 + hstep, voffB); PG8_STAGE(PG8_SA(0, 0), a2, voffA);
            PG8_WAIT_V(8); PG8_WAIT_L(0); PG8_BAR; PG8_MMA(1, 0, At, B0); PG8_MMA(1, 1, At, B1); PG8_BAR; PG8_SCHED;
            PG8_LDB(B0, 1, 0); PG8_LDB(B1, 1, 1); PG8_SCHED; PG8_LDA(At, 1, 0); PG8_STAGE(PG8_SA(0, 1), a2 + hstep, voffA);
            PG8_WAIT_V(8); PG8_WAIT_L(0); PG8_BAR; PG8_MMA(0, 0, At, B0); PG8_MMA(0, 1, At, B1); PG8_BAR; PG8_SCHED;
            PG8_LDA(At, 1, 1); PG8_STAGE(PG8_SB(1, 0), b3, voffB); PG8_STAGE(PG8_SB(1, 1), b3 + hstep, voffB); PG8_STAGE(PG8_SA(1, 0), a3, voffA);
            PG8_WAIT_V(8); PG8_WAIT_L(0); PG8_BAR; PG8_MMA(1, 0, At, B0); PG8_MMA(1, 1, At, B1); PG8_BAR; PG8_SCHED;
            } else {
            PG8_LDB(B0, 0, 0); PG8_SCHED; PG8_LDA(At, 0, 0); PG8_STAGE(PG8_SA(1, 1), a1 + hstep, voffA);
            PG8_WAIT_L(8); PG8_BAR; PG8_WAIT_L(0); PG8_MMA(0, 0, At, B0); PG8_BAR; PG8_SCHED;
            PG8_LDB(B1, 0, 1); PG8_STAGE(PG8_SB(0, 0), b2, voffB);
            PG8_BAR; PG8_WAIT_L(0); PG8_MMA(0, 1, At, B1); PG8_BAR;
            PG8_LDA(At, 0, 1); PG8_STAGE(PG8_SA(0, 0), a2, voffA);
            PG8_BAR; PG8_WAIT_L(0); PG8_MMA(1, 0, At, B0); PG8_BAR; PG8_SCHED;
            PG8_STAGE(PG8_SB(0, 1), b2 + hstep, voffB);
            PG8_WAIT_V(6); PG8_BAR; PG8_MMA(1, 1, At, B1); PG8_BAR;
            PG8_LDB(B0, 1, 0); PG8_SCHED; PG8_LDA(At, 1, 0); PG8_STAGE(PG8_SA(0, 1), a2 + hstep, voffA);
            PG8_WAIT_L(8); PG8_BAR; PG8_WAIT_L(0); PG8_MMA(0, 0, At, B0); PG8_BAR; PG8_SCHED;
            PG8_LDB(B1, 1, 1); PG8_STAGE(PG8_SB(1, 0), b3, voffB);
            PG8_BAR; PG8_WAIT_L(0); PG8_MMA(0, 1, At, B1); PG8_BAR;
            PG8_LDA(At, 1, 1); PG8_STAGE(PG8_SA(1, 0), a3, voffA);
            PG8_BAR; PG8_WAIT_L(0); PG8_MMA(1, 0, At, B0); PG8_BAR; PG8_SCHED;
            PG8_STAGE(PG8_SB(1, 1), b3 + hstep, voffB);
            PG8_WAIT_V(6); PG8_BAR; PG8_MMA(1, 1, At, B1); PG8_BAR;
            }
        }
        if constexpr (ALIGN_EPI) { if (wr == 0) PG8_BAR; }
        if constexpr (!Epi::AFTER_DRAIN) { E(acc, cur, wr, wc, fr, fq); S.done(cur); }
        if (!has_next) break;
#pragma unroll
        for (int a = 0; a < 2; ++a)
#pragma unroll
            for (int b = 0; b < 2; ++b)
#pragma unroll
                for (int m = 0; m < 4; ++m)
#pragma unroll
                    for (int n = 0; n < 2; ++n) acc[a][b][m][n] = (f32x4){0.f, 0.f, 0.f, 0.f};
        cur = nxt; cA = nA; cB = nB; ++ui;
        if constexpr (ALIGN_EPI) { if (wr == 1) PG8_BAR; }
    }
    PG8_WAIT_V(0);
    if constexpr (!ALIGN_EPI) { if (wr == 0) PG8_BAR; }
    PG8_BAR;
    if constexpr (Epi::AFTER_DRAIN) { E.fused(acc, cur, wr, wc, fr, fq, lds, wid, lane); S.done(cur); }
#undef PG8_SA
#undef PG8_SB
#undef PG8_STAGE
#undef PG8_LDA
#undef PG8_LDB
#undef PG8_MMA
#undef PG8_WAIT_V
#undef PG8_WAIT_L
#undef PG8_BAR
#undef PG8_SCHED
}
}

#define LAS __attribute__((address_space(3)))
typedef unsigned short bf16;
typedef short bf16x8 __attribute__((ext_vector_type(8)));
typedef float f32x4 __attribute__((ext_vector_type(4)));
typedef unsigned u32x4v __attribute__((ext_vector_type(4)));
typedef unsigned u32x2v __attribute__((ext_vector_type(2)));

constexpr int D = 1024, DIN = 2304, DFF = 4096, MTOT = 49152, MP = 32768, MODW = 6144;
constexpr int CHUNK_ROWS = 16384, NCHUNK = 3;
constexpr float EPS = 1e-6f, LOG2E = 1.4426950408889634f, QSCALE = 0.125f * 1.4426950408889634f;
constexpr int LDS_BAR_OFF = 153344;
constexpr int LDS_BYTES = 153600;
constexpr size_t WS_BAR = 0;
constexpr size_t MiB = 1u << 20;
constexpr size_t WS_WIN = 1 * MiB, WS_WOUT = 10 * MiB, WS_WFF1 = 14 * MiB, WS_WFF2 = 30 * MiB, WS_MOD = 46 * MiB, WS_ROPE = 47 * MiB;
constexpr size_t WS_H = 48 * MiB, WS_PROJ = 144 * MiB, WS_MIX = 360 * MiB;
constexpr size_t WS_X1B = 144 * MiB  , WS_FFH = 240 * MiB  ;
constexpr size_t WS_RSS = 46 * MiB + 256 * 1024  , WS_SW = 64 * 1024  ;
constexpr size_t FFH_BYTES = 128 * MiB;
constexpr size_t WS_VF = WS_H  , WS_KF = 456 * MiB, WS_END = 504 * MiB;

struct Params {
    const float *x_prompt, *x_sample, *c_prompt, *c_sample, *norm1_g, *norm2_g, *w_ada, *b_ada, *w_in, *qa_g, *ka_g, *a_sink, *bv_g, *w_sp, *b_sp,
        *qc_g, *kc_g, *rel_bias, *w_out, *w_ff1, *w_ff2;
    float* out; unsigned char* ws;
};

__device__ __forceinline__ float bf_lo(unsigned w) { return __uint_as_float(w << 16); }
__device__ __forceinline__ float bf_hi(unsigned w) { return __uint_as_float(w & 0xffff0000u); }
__device__ __forceinline__ unsigned pack2(float lo, float hi) { return pg8::cvt_pk_bf16(lo, hi); }
__device__ __forceinline__ float wave_sum(float v) {
#pragma unroll
    for (int o = 1; o < 64; o <<= 1) v += __shfl_xor(v, o);
    return v;
}
__device__ __forceinline__ float gelu_tanh(float x) {
    const float u = 0.7978845608028654f * (x + 0.044715f * x * x * x);
    return x * __builtin_amdgcn_rcpf(1.f + __builtin_amdgcn_exp2f(-2.f * LOG2E * u));
}
template <int CTRL> __device__ __forceinline__ float dpp_f(float v) { return __builtin_bit_cast(float, __builtin_amdgcn_update_dpp(0, __builtin_bit_cast(int, v), CTRL, 0xf, 0xf, false)); }
__device__ __forceinline__ float sum16(float s) {
    s += dpp_f<0xB1>(s); s += dpp_f<0x4E>(s); s += dpp_f<0x141>(s); s += dpp_f<0x140>(s); return s;
}
__device__ __forceinline__ f32x4 mfma16(bf16x8 a, bf16x8 b, f32x4 c) { return __builtin_amdgcn_mfma_f32_16x16x32_bf16(a, b, c, 0, 0, 0); }

__device__ __forceinline__ void transpose_item(const float* W, int K, int N, bf16* WT, LAS float* scr, int item, int lane) {
    const int nblk = N / 32, kb = item / nblk, nb = item % nblk, k0 = 64 * kb, n0 = 32 * nb;
#pragma unroll 8
    for (int i = 0; i < 32; ++i) { const int kk = 2 * i + (lane >> 5); scr[kk * 33 + (lane & 31)] = W[(size_t)(k0 + kk) * N + n0 + (lane & 31)]; }
    asm volatile("s_waitcnt lgkmcnt(0)" ::: "memory");
    const int c = lane & 7;
#pragma unroll
    for (int j = 0; j < 4; ++j) { const int n = (lane >> 3) + 8 * j; const LAS float* s = scr + (8 * c) * 33 + n;
        u32x4v o; o.x = pack2(s[0 * 33], s[1 * 33]); o.y = pack2(s[2 * 33], s[3 * 33]); o.z = pack2(s[4 * 33], s[5 * 33]); o.w = pack2(s[6 * 33], s[7 * 33]);
        *(u32x4v*)(WT + (size_t)(n0 + n) * K + k0 + 8 * c) = o; }
    asm volatile("s_waitcnt lgkmcnt(0)" ::: "memory");
}

__device__ __forceinline__ int vopaque(int v) { asm volatile("" : "+v"(v)); return v; }
__device__ __forceinline__ int sopaque(int v) { asm volatile("" : "+s"(v)); return v; }
typedef const __attribute__((address_space(4))) Params* KPtr;
__device__ __forceinline__ KPtr kopaque(KPtr q) { asm volatile("" : "+s"(q)); return q; }
template <int SEL> __device__ __forceinline__ void transposes(KPtr kp, LAS unsigned char* lds, int gw, int NGW, int wave, int lane) {
    KPtr p = kopaque(kp); unsigned char* ws = p->ws;
    LAS float* scr = (LAS float*)(lds + wave * 16384);
    constexpr int I_IN = 16 * 72, I_OUT = 16 * 32, I_F1 = 16 * 128, I_F2 = 64 * 32;
    if (SEL == 0) { for (int it = gw; it < 2 * I_IN; it += NGW) { const int l = it / I_IN, r = it % I_IN;
        transpose_item(p->w_in + (size_t)l * D * DIN, D, DIN, (bf16*)(ws + WS_WIN) + (size_t)l * DIN * D, scr, r, lane); } }
    if (SEL == 1) { for (int it = gw; it < 2 * I_OUT; it += NGW) { const int l = it / I_OUT, r = it % I_OUT;
        transpose_item(p->w_out + (size_t)l * D * D, D, D, (bf16*)(ws + WS_WOUT) + (size_t)l * D * D, scr, r, lane); } }
    if (SEL == 2) { for (int it = gw; it < 2 * (I_F1 + I_F2); it += NGW) { const int l = it / (I_F1 + I_F2), r = it % (I_F1 + I_F2);
        if (r < I_F1) transpose_item(p->w_ff1 + (size_t)l * D * DFF, D, DFF, (bf16*)(ws + WS_WFF1) + (size_t)l * DFF * D, scr, r, lane);
        else transpose_item(p->w_ff2 + (size_t)l * DFF * D, DFF, D, (bf16*)(ws + WS_WFF2) + (size_t)l * D * DFF, scr, r - I_F1, lane); } }
}
__device__ __forceinline__ void phase0a(KPtr kp, LAS unsigned char* lds, int tid, int wave, int lane) {
    KPtr p = kopaque(kp); unsigned char* ws = p->ws;
    {
        float* z0 = (float*)(ws + WS_MOD); float* z1 = (float*)(ws + WS_SW);
        for (int i = blockIdx.x * 512 + tid; i < (1 << 18); i += gridDim.x * 512) z0[i] = 0.f;
        for (int i = blockIdx.x * 512 + tid; i < 4 * 5 * 4096; i += gridDim.x * 512) z1[i] = 0.f;
    }
    {
        float* rc = (float*)(ws + WS_ROPE); float* rs = rc + 16384 * 8;
        for (int i = blockIdx.x * 512 + tid; i < 16384 * 8; i += gridDim.x * 512) {
            const int pos = i >> 3, f = i & 7;
            const float inv = f == 0 ? 1.0f : f == 1 ? 0.19392274474868576f : f == 2 ? 0.03760603093086393f : f == 3 ? 0.007292664737217109f :
                              f == 4 ? 0.001414213562373095f : f == 5 ? 0.0002742481756762073f : f == 6 ? 5.318295896944988e-05f : 1.031338537721246e-05f;
            const float ang = (float)pos * inv;
            double rev = (double)ang * 0.15915494309189535; rev -= __builtin_floor(rev);
            rc[i] = __builtin_amdgcn_cosf((float)rev); rs[i] = __builtin_amdgcn_sinf((float)rev);
        }
    }
    transposes<0>(kp, lds, blockIdx.x * 8 + wave, gridDim.x * 8, wave, lane);
}
__device__ __forceinline__ void phase0b(KPtr kp, LAS unsigned char* lds, int gw, int NGW, int wave, int lane) {
    KPtr p = kopaque(kp); unsigned char* ws = p->ws;
    float* mod = (float*)(ws + WS_MOD);
    LAS float* sl = (LAS float*)(lds + wave * 16384);
    for (int item = gw; item < 1536; item += NGW) {
        const int ks = item & 7, r = item >> 3, l = r / 96, col0 = (r % 96) * 64;
        for (int i = lane; i < 640; i += 64) { const int b = i >> 7, k = ks * 128 + (i & 127); const float c = (b < 4) ? p->c_prompt[b * 1024 + k] : p->c_sample[k];
            sl[i] = c * __builtin_amdgcn_rcpf(1.f + __expf(-c)); }
        asm volatile("s_waitcnt lgkmcnt(0)" ::: "memory");
        const float* W = p->w_ada + (size_t)l * 1024 * MODW + (size_t)ks * 128 * MODW + col0 + lane;
        float a0 = 0.f, a1 = 0.f, a2 = 0.f, a3 = 0.f, a4 = 0.f;
#pragma unroll 16
        for (int kk = 0; kk < 128; ++kk) { const float w = W[(size_t)kk * MODW];
            a0 += sl[kk] * w; a1 += sl[128 + kk] * w; a2 += sl[256 + kk] * w; a3 += sl[384 + kk] * w; a4 += sl[512 + kk] * w; }
        if (ks == 0) { const float bb = p->b_ada[l * MODW + col0 + lane]; a0 += bb; a1 += bb; a2 += bb; a3 += bb; a4 += bb; }
        float* m = mod + (size_t)(l * 5) * MODW + col0 + lane;
        __hip_atomic_fetch_add(m, a0, __ATOMIC_RELAXED, __HIP_MEMORY_SCOPE_AGENT); __hip_atomic_fetch_add(m + MODW, a1, __ATOMIC_RELAXED, __HIP_MEMORY_SCOPE_AGENT);
        __hip_atomic_fetch_add(m + 2 * MODW, a2, __ATOMIC_RELAXED, __HIP_MEMORY_SCOPE_AGENT); __hip_atomic_fetch_add(m + 3 * MODW, a3, __ATOMIC_RELAXED, __HIP_MEMORY_SCOPE_AGENT);
        __hip_atomic_fetch_add(m + 4 * MODW, a4, __ATOMIC_RELAXED, __HIP_MEMORY_SCOPE_AGENT);
        asm volatile("s_waitcnt lgkmcnt(0)" ::: "memory");
    }
    transposes<1>(kp, lds, gw, NGW, wave, lane);
}

__device__ __forceinline__ void xa_phase(const float* xa, const float* xb, int split, const float* g, const float* scale  , bf16* H, float* rss, int gw, int NGW, int lane_in) {
    const int lane = vopaque(lane_in);
    f32x4 vn[4];
    if (gw < MTOT) { const float* xrow = (gw < split) ? xa + (size_t)gw * D : xb + (size_t)(gw - split) * D; const f32x4* xr = (const f32x4*)xrow + lane;
#pragma unroll
        for (int j = 0; j < 4; ++j) vn[j] = xr[64 * j]; }
    for (int m = gw; m < MTOT; m += NGW) {
        int b = m >> 13; b = b > 4 ? 4 : b;
        f32x4 v[4]; float ss = 0.f;
#pragma unroll
        for (int j = 0; j < 4; ++j) { v[j] = vn[j]; ss += (v[j].x * v[j].x + v[j].y * v[j].y) + (v[j].z * v[j].z + v[j].w * v[j].w); }
        const int mn = m + NGW;
        if (mn < MTOT) { const float* xrow = (mn < split) ? xa + (size_t)mn * D : xb + (size_t)(mn - split) * D; const f32x4* xr = (const f32x4*)xrow + lane;
#pragma unroll
            for (int j = 0; j < 4; ++j) vn[j] = xr[64 * j]; }
        f32x4 gg[4], sc[4];
#pragma unroll
        for (int j = 0; j < 4; ++j) { const int col = 256 * j + 4 * lane; gg[j] = *(const f32x4*)(g + col); sc[j] = *(const f32x4*)(scale + (size_t)b * MODW + col); }
        __builtin_amdgcn_sched_barrier(0);
        ss = wave_sum(ss);
        if (lane == 0) rss[m] = ss;
        u32x2v* o = (u32x2v*)(H + (size_t)m * D) + lane;
#pragma unroll
        for (int j = 0; j < 4; ++j) {
            const f32x4 y = v[j] * gg[j] * (sc[j] + 1.f);
            u32x2v w; w.x = pack2(y.x, y.y); w.y = pack2(y.z, y.w); o[64 * j] = w; }
    }
}
__device__ __forceinline__ void sw_phase(const float* mod, const float* w_in, const float* w_ff1, float* sW, LAS unsigned char* lds, int gw, int NGW, int wave, int lane) {
    LAS float* sl = (LAS float*)(lds + wave * 16384);
    for (int item = gw; item < 1600; item += NGW) {
        const int ks = item & 7, r0 = item >> 3, l = r0 / 100, r = r0 % 100, which = r < 36 ? 0 : 1, cc = which ? r - 36 : r, N = which ? DFF : DIN, col0 = cc * 64;
        const float* sh = mod + (size_t)l * 5 * MODW + (which ? 3 * D : 0) + ks * 128;
        for (int i = lane; i < 640; i += 64) sl[i] = sh[(size_t)(i >> 7) * MODW + (i & 127)];
        asm volatile("s_waitcnt lgkmcnt(0)" ::: "memory");
        const float* W = (which ? w_ff1 + (size_t)l * D * DFF : w_in + (size_t)l * D * DIN) + (size_t)ks * 128 * N + col0 + lane;
        float a0 = 0.f, a1 = 0.f, a2 = 0.f, a3 = 0.f, a4 = 0.f;
#pragma unroll 16
        for (int kk = 0; kk < 128; ++kk) { const float w = W[(size_t)kk * N];
            a0 += sl[kk] * w; a1 += sl[128 + kk] * w; a2 += sl[256 + kk] * w; a3 += sl[384 + kk] * w; a4 += sl[512 + kk] * w; }
        float* o = sW + ((size_t)(l * 2 + which) * 5) * 4096 + col0 + lane;
        __hip_atomic_fetch_add(o, a0, __ATOMIC_RELAXED, __HIP_MEMORY_SCOPE_AGENT); __hip_atomic_fetch_add(o + 4096, a1, __ATOMIC_RELAXED, __HIP_MEMORY_SCOPE_AGENT);
        __hip_atomic_fetch_add(o + 2 * 4096, a2, __ATOMIC_RELAXED, __HIP_MEMORY_SCOPE_AGENT); __hip_atomic_fetch_add(o + 3 * 4096, a3, __ATOMIC_RELAXED, __HIP_MEMORY_SCOPE_AGENT);
        __hip_atomic_fetch_add(o + 4 * 4096, a4, __ATOMIC_RELAXED, __HIP_MEMORY_SCOPE_AGENT);
        asm volatile("s_waitcnt lgkmcnt(0)" ::: "memory");
    }
}

__device__ __forceinline__ int prep_unit(int gidx, int grp) { return gidx == 0 ? 6 + grp : gidx == 1 ? 14 + grp : 24 + (gidx - 2) * 4 + grp; }
__device__ __forceinline__ void prep_task(int task, const bf16* P, bf16* KF, bf16* VF, const float* ka_g, const float* bv_g, const float* kc_g,
                                          const float* ropeC, const float* ropeS, LAS unsigned char* wlds, int lane) {
    const int tb = task / 5, gidx = task % 5;
    const int sub = lane & 15, grp = lane >> 4;
    const int u = prep_unit(gidx, grp);
    const bool isk = (u >= 6 && u < 8) || (u >= 24 && u < 30), isbv = (u >= 14 && u < 18);
    const bool isv = !isk;
    const bf16* base = P + (size_t)tb * 16 * DIN + u * 64 + 4 * sub;
    const float* gp = (u < 8) ? ka_g : kc_g;
    const f32x4 gg = *(const f32x4*)(gp + 4 * sub);
    f32x4 g2 = {1.f, 1.f, 1.f, 1.f};
    if (isbv) g2 = *(const f32x4*)(bv_g + (u - 14) * 64 + 4 * sub);
    const int m0 = tb * 16, pos0 = (m0 < MP) ? (m0 & 8191) : (m0 - MP);
    LAS unsigned char* reg = wlds + grp * 2048;
    const int c = sub >> 1;
    u32x2v rawn[4];
#pragma unroll
    for (int j = 0; j < 4; ++j) rawn[j] = *(const u32x2v*)(base + (size_t)j * DIN);
#pragma unroll 1
    for (int tq4 = 0; tq4 < 4; ++tq4) {
        u32x2v raw[4];
#pragma unroll
        for (int j = 0; j < 4; ++j) raw[j] = rawn[j];
        if (tq4 < 3) {
#pragma unroll
            for (int j = 0; j < 4; ++j) rawn[j] = *(const u32x2v*)(base + (size_t)(4 * tq4 + 4 + j) * DIN);
        }
        float vk[4][4];
#pragma unroll
        for (int j = 0; j < 4; ++j) {
            const int tk = 4 * tq4 + j;
            float x[4] = {bf_lo(raw[j].x), bf_hi(raw[j].x), bf_lo(raw[j].y), bf_hi(raw[j].y)};
            float o[4];
            if (gidx == 1) {
                float sq = sum16((x[0] * x[0] + x[1] * x[1]) + (x[2] * x[2] + x[3] * x[3])); sq += __shfl_xor(sq, 16); sq += __shfl_xor(sq, 32);
                const float r2 = __builtin_amdgcn_rsqf(sq * (1.f / 256.f) + EPS);
                o[0] = x[0] * r2 * g2.x; o[1] = x[1] * r2 * g2.y; o[2] = x[2] * r2 * g2.z; o[3] = x[3] * r2 * g2.w;
            } else if (gidx == 4) {
#pragma unroll
                for (int i = 0; i < 4; ++i) o[i] = x[i];
            } else {
                float ss = sum16((x[0] * x[0] + x[1] * x[1]) + (x[2] * x[2] + x[3] * x[3]));
                const float rinv = __builtin_amdgcn_rsqf(ss * (1.f / 64.f) + EPS);
                float y[4] = {x[0] * rinv * gg.x, x[1] * rinv * gg.y, x[2] * rinv * gg.z, x[3] * rinv * gg.w};
                if (gidx == 0) {
                    float yp[4];
#pragma unroll
                    for (int i = 0; i < 4; ++i) yp[i] = dpp_f<0x4E>(y[i]);
                    if (sub < 4) {
                        const f32x4 c4 = *(const f32x4*)(ropeC + (pos0 + tk) * 8 + 4 * (sub & 1)), s4 = *(const f32x4*)(ropeS + (pos0 + tk) * 8 + 4 * (sub & 1));
                        const float sg = (sub < 2) ? -1.f : 1.f;
                        y[0] = y[0] * c4.x + sg * yp[0] * s4.x; y[1] = y[1] * c4.y + sg * yp[1] * s4.y; y[2] = y[2] * c4.z + sg * yp[2] * s4.z; y[3] = y[3] * c4.w + sg * yp[3] * s4.w;
                    }
                }
#pragma unroll
                for (int i = 0; i < 4; ++i) o[i] = isk ? y[i] : x[i];
            }
            if (isk) { u32x2v w; w.x = pack2(o[0], o[1]); w.y = pack2(o[2], o[3]);
                *(LAS u32x2v*)(reg + (c * 16 + (tk ^ c)) * 16 + (sub & 1) * 8) = w; }
#pragma unroll
            for (int i = 0; i < 4; ++i) vk[j][i] = o[i];
        }
        if (isv) {
#pragma unroll
            for (int i = 0; i < 4; ++i) { const int d = 4 * sub + i;
                u32x2v w; w.x = pack2(vk[0][i], vk[1][i]); w.y = pack2(vk[2][i], vk[3][i]);
                *(LAS u32x2v*)(reg + (((d >> 4) * 4 + tq4) * 16 + (d & 15)) * 8) = w; }
        }
    }
    asm volatile("s_waitcnt lgkmcnt(0)" ::: "memory");
#pragma unroll
    for (int r = 0; r < 4; ++r) {
        const int ur = prep_unit(gidx, r);
        const bool rk = (ur >= 6 && ur < 8) || (ur >= 24 && ur < 30), rv = (ur >= 8 && ur < 10) || (ur >= 14 && ur < 18) || (ur >= 30);
        if (rk) {
            const int kh = (ur < 8) ? (ur - 6) : (ur - 22);
            bf16* dst = KF + ((size_t)tb * 8 + kh) * 1024 + lane * 8;
            const int c0 = lane >> 4, f0 = lane & 15;
            const u32x4v d0 = *(const LAS u32x4v*)(wlds + r * 2048 + (c0 * 16 + (f0 ^ c0)) * 16);
            const u32x4v d1 = *(const LAS u32x4v*)(wlds + r * 2048 + ((c0 + 4) * 16 + (f0 ^ (c0 + 4))) * 16);
            *(u32x4v*)dst = d0; *(u32x4v*)(dst + 512) = d1;
        } else if (rv) {
            const int vh = (ur < 10) ? (ur - 8) : (ur < 18) ? (ur - 12) : (ur - 24);
            bf16* dst = VF + ((size_t)tb * 12 + vh) * 1024 + lane * 8;
            const u32x4v d0 = *(const LAS u32x4v*)(wlds + r * 2048 + lane * 16), d1 = *(const LAS u32x4v*)(wlds + r * 2048 + 1024 + lane * 16);
            *(u32x4v*)dst = d0; *(u32x4v*)(dst + 512) = d1;
        }
    }
    asm volatile("s_waitcnt lgkmcnt(0)" ::: "memory");
}

__device__ __forceinline__ bf16x8 vf_frag(const bf16* p0, const bf16* p1) {
    const u32x2v lo = *(const u32x2v*)p0, hi = *(const u32x2v*)p1;
    u32x4v w; w.x = lo.x; w.y = lo.y; w.z = hi.x; w.w = hi.y; return __builtin_bit_cast(bf16x8, w);
}
__device__ __forceinline__ bf16x8 pack_p(const f32x4& a, const f32x4& b) {
    u32x4v w; w.x = pack2(a.x, a.y); w.y = pack2(a.z, a.w); w.z = pack2(b.x, b.y); w.w = pack2(b.z, b.w); return __builtin_bit_cast(bf16x8, w);
}

__device__ __forceinline__ void dma1k(const bf16* gsrc_lane, LAS unsigned char* ldst) {
    __builtin_amdgcn_global_load_lds((const unsigned*)gsrc_lane, (LAS unsigned*)ldst, 16, 0, 0);
}
__device__ __forceinline__ bf16x8 lds_vfrag(const LAS unsigned char* p0, const LAS unsigned char* p1) {
    const u32x2v lo = *(const LAS u32x2v*)p0, hi = *(const LAS u32x2v*)p1;
    u32x4v w; w.x = lo.x; w.y = lo.y; w.z = hi.x; w.w = hi.y; return __builtin_bit_cast(bf16x8, w);
}

template <bool ROPE> __device__ __forceinline__ void q_prep(bf16x8& q0, bf16x8& q1, const float* g, const float* ropeC, const float* ropeS, int pos, int fq) {
    const u32x4v a = __builtin_bit_cast(u32x4v, q0), b = __builtin_bit_cast(u32x4v, q1);
    float x0[8] = {bf_lo(a.x), bf_hi(a.x), bf_lo(a.y), bf_hi(a.y), bf_lo(a.z), bf_hi(a.z), bf_lo(a.w), bf_hi(a.w)};
    float x1[8] = {bf_lo(b.x), bf_hi(b.x), bf_lo(b.y), bf_hi(b.y), bf_lo(b.z), bf_hi(b.z), bf_lo(b.w), bf_hi(b.w)};
    float ss = 0.f;
#pragma unroll
    for (int j = 0; j < 8; ++j) ss += x0[j] * x0[j] + x1[j] * x1[j];
    ss += __shfl_xor(ss, 16); ss += __shfl_xor(ss, 32);
    const float sc = __builtin_amdgcn_rsqf(ss * (1.f / 64.f) + EPS) * QSCALE;
    const f32x4 g0a = *(const f32x4*)(g + 8 * fq), g0b = *(const f32x4*)(g + 8 * fq + 4), g1a = *(const f32x4*)(g + 32 + 8 * fq), g1b = *(const f32x4*)(g + 36 + 8 * fq);
    const float gv0[8] = {g0a.x, g0a.y, g0a.z, g0a.w, g0b.x, g0b.y, g0b.z, g0b.w}, gv1[8] = {g1a.x, g1a.y, g1a.z, g1a.w, g1b.x, g1b.y, g1b.z, g1b.w};
#pragma unroll
    for (int j = 0; j < 8; ++j) { x0[j] *= sc * gv0[j]; x1[j] *= sc * gv1[j]; }
    if (ROPE) {
        float pr[8];
#pragma unroll
        for (int j = 0; j < 8; ++j) pr[j] = __shfl_xor(x0[j], 16);
        if (fq < 2) {
            const f32x4 ca = *(const f32x4*)(ropeC + pos * 8), cb = *(const f32x4*)(ropeC + pos * 8 + 4), sa = *(const f32x4*)(ropeS + pos * 8), sb = *(const f32x4*)(ropeS + pos * 8 + 4);
            const float cv[8] = {ca.x, ca.y, ca.z, ca.w, cb.x, cb.y, cb.z, cb.w}, sv[8] = {sa.x, sa.y, sa.z, sa.w, sb.x, sb.y, sb.z, sb.w};
            const float sg = (fq == 0) ? -1.f : 1.f;
#pragma unroll
            for (int j = 0; j < 8; ++j) x0[j] = x0[j] * cv[j] + sg * pr[j] * sv[j];
        }
    }
    u32x4v oa, ob;
    oa.x = pack2(x0[0], x0[1]); oa.y = pack2(x0[2], x0[3]); oa.z = pack2(x0[4], x0[5]); oa.w = pack2(x0[6], x0[7]);
    ob.x = pack2(x1[0], x1[1]); ob.y = pack2(x1[2], x1[3]); ob.z = pack2(x1[4], x1[5]); ob.w = pack2(x1[6], x1[7]);
    q0 = __builtin_bit_cast(bf16x8, oa); q1 = __builtin_bit_cast(bf16x8, ob);
}

__device__ __forceinline__ void mixer_b_task(int task, const bf16* P, const bf16* VF, bf16* MIX, const float* w_sp, const float* b_sp, int lane);
__device__ __forceinline__ void mixer_a_item(int idx, const bf16* P, const bf16* KF, const bf16* VF, bf16* MIX, const float* sink, const float* qg, const float* ropeC, LAS unsigned char* lds, int wave, int lane, int btask, const float* w_sp, const float* b_sp) {
    const int blkg = idx >> 1, kvh = idx & 1;
    int n, S, row0;
    if (blkg < 256) { n = blkg & 63; S = 8192; row0 = (blkg >> 6) * 8192; } else { n = blkg - 256; S = 16384; row0 = MP; }
    const int tb0 = (row0 >> 4) + 8 * (n - 1), tblo = row0 >> 4, tbhi = ((row0 + S) >> 4) - 1;
    LAS unsigned char* Kl = lds; LAS unsigned char* Vl = lds + 49152;
#pragma unroll 1
    for (int j = 0; j < 12; ++j) {
        const int i = wave + 8 * j, which = i / 48, rem = i % 48, blk = rem >> 1, half = rem & 1;
        int tb = tb0 + blk; tb = tb < tblo ? tblo : tb; tb = tb > tbhi ? tbhi : tb;
        const bf16* src = which ? VF + ((size_t)tb * 12 + kvh) * 1024 + half * 512 + lane * 8 : KF + ((size_t)tb * 8 + kvh) * 1024 + half * 512 + lane * 8;
        dma1k(src, (which ? Vl : Kl) + blk * 2048 + half * 1024);
    }
    const int fr = lane & 15, fq = lane >> 4;
    const int tq = row0 + 128 * n + 16 * wave;
    bf16x8 qf[3][2];
#pragma unroll
    for (int g = 0; g < 3; ++g) { const bf16* qp = P + (size_t)(tq + fr) * DIN + (kvh * 3 + g) * 64 + 8 * fq; qf[g][0] = *(const bf16x8*)qp; qf[g][1] = *(const bf16x8*)(qp + 32); }
#pragma unroll
    for (int g = 0; g < 3; ++g) q_prep<true>(qf[g][0], qf[g][1], qg, ropeC, ropeC + 16384 * 8, 128 * n + 16 * wave + fr, fq);
    if (btask < 12288) mixer_b_task(btask, P, VF, MIX, w_sp, b_sp, lane);
    asm volatile("s_waitcnt vmcnt(0)" ::: "memory");
    __syncthreads();
#pragma unroll 1
    for (int g = 0; g < 3; ++g) {
        const int head = kvh * 3 + g;
        const bf16x8 q0 = g == 0 ? qf[0][0] : g == 1 ? qf[1][0] : qf[2][0], q1 = g == 0 ? qf[0][1] : g == 1 ? qf[1][1] : qf[2][1];
        f32x4 s[18];
#pragma unroll
        for (int kb = 0; kb < 17; ++kb) {
            int blk = wave + kb; blk = blk > 23 ? 23 : blk;
            const LAS unsigned char* kp = Kl + blk * 2048 + lane * 16;
            const bf16x8 k0 = *(const LAS bf16x8*)kp, k1 = *(const LAS bf16x8*)(kp + 1024);
            f32x4 acc = {0.f, 0.f, 0.f, 0.f};
            acc = mfma16(k0, q0, acc); acc = mfma16(k1, q1, acc); s[kb] = acc;
        }
        const float sk2 = sink[head] * LOG2E;
        float mx = sk2;
#pragma unroll
        for (int kb = 0; kb < 17; ++kb)
#pragma unroll
            for (int i = 0; i < 4; ++i) {
                const int rel = 16 * kb + 4 * fq + i - fr;
                const int kpos = 128 * (n - 1) + (wave + kb) * 16 + 4 * fq + i;
                const bool ok = rel >= 0 && rel <= 256 && kpos >= 0 && kpos < S;
                const float v = ok ? s[kb][i] : -1e30f; s[kb][i] = v; mx = fmaxf(mx, v);
            }
        mx = fmaxf(mx, __shfl_xor(mx, 16)); mx = fmaxf(mx, __shfl_xor(mx, 32));
        float sum = 0.f;
#pragma unroll
        for (int kb = 0; kb < 17; ++kb)
#pragma unroll
            for (int i = 0; i < 4; ++i) { const float pe = __builtin_amdgcn_exp2f(s[kb][i] - mx); s[kb][i] = pe; sum += pe; }
        s[17] = (f32x4){0.f, 0.f, 0.f, 0.f};
        sum += __shfl_xor(sum, 16); sum += __shfl_xor(sum, 32);
        const float inv = 1.f / (sum + __builtin_amdgcn_exp2f(sk2 - mx));
        f32x4 o[4];
#pragma unroll
        for (int db = 0; db < 4; ++db) o[db] = (f32x4){0.f, 0.f, 0.f, 0.f};
#pragma unroll
        for (int pp = 0; pp < 9; ++pp) {
            const bf16x8 pb = pack_p(s[2 * pp], s[2 * pp + 1]);
            int b0 = wave + 2 * pp, b1 = b0 + 1; b0 = b0 > 23 ? 23 : b0; b1 = b1 > 23 ? 23 : b1;
#pragma unroll
            for (int db = 0; db < 4; ++db) o[db] = mfma16(lds_vfrag(Vl + b0 * 2048 + db * 512 + lane * 8, Vl + b1 * 2048 + db * 512 + lane * 8), pb, o[db]);
        }
        bf16* op = MIX + (size_t)(tq + fr) * D + head * 64 + 4 * fq;
#pragma unroll
        for (int db = 0; db < 4; ++db) { const f32x4 v = o[db] * inv; u32x2v wv_; wv_.x = pack2(v.x, v.y); wv_.y = pack2(v.z, v.w); *(u32x2v*)(op + 16 * db) = wv_; }
    }
    __syncthreads();
}

__device__ __forceinline__ void mixer_c_item(int idx, const bf16* P, const bf16* KF, const bf16* VF, bf16* MIX, const float* rel_bias, const float* qg, LAS unsigned char* lds, int tid, int wave, int lane, int btask, const float* w_sp, const float* b_sp) {
    const int rp = idx / 6, h = idx % 6;
    int r0, rows, tok0;
    if (rp < 256) { r0 = 2 * (rp & 63); rows = 128; tok0 = (rp >> 6) * 8192; } else { r0 = 2 * (rp - 256); rows = 256; tok0 = MP; }
    int rs0 = r0 - 4; rs0 = rs0 < 0 ? 0 : rs0; rs0 = rs0 > rows - 8 ? rows - 8 : rs0;
    LAS unsigned char* Kl = lds; LAS unsigned char* Vl = lds + 73728; LAS float* biasL = (LAS float*)(lds + 147456);
#pragma unroll 1
    for (int j = 0; j < 18; ++j) {
        const int i = wave + 8 * j, which = i / 72, rem = i % 72, blk = rem >> 1, half = rem & 1;
        int krow = rs0 + (blk >> 2); krow = krow > rows - 1 ? rows - 1 : krow;
        const int tb = (tok0 >> 4) + krow * 4 + (blk & 3);
        const bf16* src = which ? VF + ((size_t)tb * 12 + 6 + h) * 1024 + half * 512 + lane * 8 : KF + ((size_t)tb * 8 + 2 + h) * 1024 + half * 512 + lane * 8;
        dma1k(src, (which ? Vl : Kl) + blk * 2048 + half * 1024);
    }
    if (tid < 465) biasL[tid] = rel_bias[h * 465 + tid] * LOG2E;
    const int fr = lane & 15, fq = lane >> 4;
    const int r = r0 + (wave >> 2), j = wave & 3;
    int rs = r - 4; rs = rs < 0 ? 0 : rs; rs = rs > rows - 8 ? rows - 8 : rs;
    const int cb0 = j < 2 ? 0 : 1;
    const int qc = 16 * j + fr;
    const int tq = tok0 + r * 64 + 16 * j;
    int cs = qc - 8; cs = cs < 0 ? 0 : cs; cs = cs > 48 ? 48 : cs;
    const bf16* qp = P + (size_t)(tq + fr) * DIN + 1152 + h * 64 + 8 * fq;
    bf16x8 q0 = *(const bf16x8*)qp, q1 = *(const bf16x8*)(qp + 32);
    q_prep<false>(q0, q1, qg, nullptr, nullptr, 0, fq);
    if (btask < 12288) mixer_b_task(btask, P, VF, MIX, w_sp, b_sp, lane);
    asm volatile("s_waitcnt vmcnt(0)" ::: "memory");
    __syncthreads();
    const int lb0 = (rs - rs0) * 4 + cb0;
    f32x4 s[24];
#pragma unroll
    for (int kb = 0; kb < 24; ++kb) {
        const LAS unsigned char* kp = Kl + (lb0 + 4 * (kb / 3) + kb % 3) * 2048 + lane * 16;
        const bf16x8 k0 = *(const LAS bf16x8*)kp, k1 = *(const LAS bf16x8*)(kp + 1024);
        f32x4 acc = {0.f, 0.f, 0.f, 0.f};
        acc = mfma16(k0, q0, acc); acc = mfma16(k1, q1, acc); s[kb] = acc;
    }
    float mx = -1e30f;
#pragma unroll
    for (int kb = 0; kb < 24; ++kb) {
        const int kr = kb / 3, t = kb % 3;
        const int dr = rs + kr - r + 7;
#pragma unroll
        for (int i = 0; i < 4; ++i) {
            const int kc = 16 * (cb0 + t) + 4 * fq + i;
            const bool ok = kc >= cs && kc < cs + 16;
            int dc = kc - qc + 15; dc = dc < 0 ? 0 : dc; dc = dc > 30 ? 30 : dc;
            const float v = ok ? s[kb][i] + biasL[dr * 31 + dc] : -1e30f; s[kb][i] = v; mx = fmaxf(mx, v);
        }
    }
    mx = fmaxf(mx, __shfl_xor(mx, 16)); mx = fmaxf(mx, __shfl_xor(mx, 32));
    float sum = 0.f;
#pragma unroll
    for (int kb = 0; kb < 24; ++kb)
#pragma unroll
        for (int i = 0; i < 4; ++i) { const float pe = __builtin_amdgcn_exp2f(s[kb][i] - mx); s[kb][i] = pe; sum += pe; }
    sum += __shfl_xor(sum, 16); sum += __shfl_xor(sum, 32);
    const float inv = 1.f / sum;
    f32x4 o[4];
#pragma unroll
    for (int db = 0; db < 4; ++db) o[db] = (f32x4){0.f, 0.f, 0.f, 0.f};
#pragma unroll
    for (int pp = 0; pp < 12; ++pp) {
        const bf16x8 pb = pack_p(s[2 * pp], s[2 * pp + 1]);
        const int kb0 = 2 * pp, kb1 = 2 * pp + 1;
        const LAS unsigned char* v0 = Vl + (lb0 + 4 * (kb0 / 3) + kb0 % 3) * 2048 + lane * 8; const LAS unsigned char* v1 = Vl + (lb0 + 4 * (kb1 / 3) + kb1 % 3) * 2048 + lane * 8;
#pragma unroll
        for (int db = 0; db < 4; ++db) o[db] = mfma16(lds_vfrag(v0 + db * 512, v1 + db * 512), pb, o[db]);
    }
    bf16* op = MIX + (size_t)(tq + fr) * D + 640 + h * 64 + 4 * fq;
#pragma unroll
    for (int db = 0; db < 4; ++db) { const f32x4 v = o[db] * inv; u32x2v wv_; wv_.x = pack2(v.x, v.y); wv_.y = pack2(v.z, v.w); *(u32x2v*)(op + 16 * db) = wv_; }
    __syncthreads();
}

__device__ __forceinline__ void mixer_b_task(int task, const bf16* P, const bf16* VF, bf16* MIX, const float* w_sp, const float* b_sp, int lane) {
    const int g = task / 3072, p16 = task % 3072;
    const int fr = lane & 15, fq = lane >> 4;
    const int pt = (p16 & 7) * 16 + fr;
    const int tbc = p16 & ~7;
    const size_t tok = (size_t)p16 * 16 + fr;
    f32x4 wv[4][2];
#pragma unroll
    for (int ks = 0; ks < 4; ++ks) { const float* wp = w_sp + (size_t)(g * 128 + pt) * 128 + 32 * ks + 4 * fq; wv[ks][0] = *(const f32x4*)wp; wv[ks][1] = *(const f32x4*)(wp + 16); }
    const bf16* vfl = VF + ((size_t)tbc * 12 + 2 + g) * 1024 + lane * 4;
    bf16x8 vf[4][4];
#pragma unroll
    for (int ks = 0; ks < 4; ++ks)
#pragma unroll
        for (int eb = 0; eb < 4; ++eb) vf[ks][eb] = vf_frag(vfl + (size_t)(2 * ks) * 12288 + eb * 256, vfl + (size_t)(2 * ks + 1) * 12288 + eb * 256);
    u32x2v uus[4];
#pragma unroll
    for (int eb = 0; eb < 4; ++eb) uus[eb] = *(const u32x2v*)(P + tok * DIN + 640 + g * 64 + 16 * eb + 4 * fq);
    const float bias = b_sp[g * 128 + pt];
    f32x4 d[4];
#pragma unroll
    for (int eb = 0; eb < 4; ++eb) d[eb] = (f32x4){0.f, 0.f, 0.f, 0.f};
#pragma unroll
    for (int ks = 0; ks < 4; ++ks) {
        const bf16x8 bw = pack_p(wv[ks][0], wv[ks][1]);
#pragma unroll
        for (int eb = 0; eb < 4; ++eb) d[eb] = mfma16(vf[ks][eb], bw, d[eb]);
    }
#pragma unroll
    for (int eb = 0; eb < 4; ++eb) {
        const u32x2v uu = uus[eb];
        const float o0 = bf_lo(uu.x) * (d[eb].x + bias), o1 = bf_hi(uu.x) * (d[eb].y + bias), o2 = bf_lo(uu.y) * (d[eb].z + bias), o3 = bf_hi(uu.y) * (d[eb].w + bias);
        u32x2v w; w.x = pack2(o0, o1); w.y = pack2(o2, o3);
        *(u32x2v*)(MIX + tok * D + 384 + g * 64 + 16 * eb + 4 * fq) = w;
    }
}

#define XB_TMO      128
#define XB_XCNT(j)  (256  + 64 * (j))
#define XB_XSUB(j)  (1280 + 64 * (j))
#define XB_XGEN(j)  (2304 + 64 * (j))
#define XB_TOP      3328
#define XB_TOPGEN   3392
#define XCD_BAR_WORDS 3456
#define XB_SPIN_CAP (1u << 18)

__device__ __forceinline__ unsigned xb_ld(unsigned* p)              { return __hip_atomic_load(p, __ATOMIC_RELAXED, __HIP_MEMORY_SCOPE_AGENT); }
__device__ __forceinline__ unsigned xb_add(unsigned* p, unsigned v) { return __hip_atomic_fetch_add(p, v, __ATOMIC_RELAXED, __HIP_MEMORY_SCOPE_AGENT); }
__device__ __forceinline__ unsigned xb_xcc_id() { return (unsigned)__builtin_amdgcn_s_getreg((3 << 11) | 20) & 0xFu; }
#define XB_SPIN(cond, bar) do { unsigned _sp = 0; while (cond) { __builtin_amdgcn_s_sleep(1); \
    if ((++_sp & 255u) == 0u) { if (xb_ld(&(bar)[XB_TMO])) break; if (_sp > XB_SPIN_CAP) { atomicAdd(&(bar)[XB_TMO], 1u); break; } } } } while (0)

struct XcdBarrier {
    unsigned* bar; unsigned x;
    volatile LAS unsigned* st;
};

__device__ __forceinline__ XcdBarrier xcd_barrier_post(unsigned* bar, volatile LAS unsigned* st) {
    XcdBarrier b; b.bar = bar; b.x = xb_xcc_id(); b.st = st;
    if (threadIdx.x == 0) (void)xb_add(&bar[XB_XCNT(b.x)], 1u);
    return b;
}
__device__ __forceinline__ void xcd_barrier_complete(unsigned* bar, unsigned x, unsigned& nloc, unsigned& nx) {
    const unsigned G = gridDim.x * gridDim.y * gridDim.z;
    unsigned sum, cnt, mine, sp = 0u;
    for (;;) {
        sum = 0u; cnt = 0u; mine = 0u;
#pragma unroll
        for (unsigned j = 0; j < 16; ++j) { const unsigned c = xb_ld(&bar[XB_XCNT(j)]); sum += c; cnt += (c > 0u) ? 1u : 0u; mine = (j == x) ? c : mine; }
        if (sum == G) break;
        __builtin_amdgcn_s_sleep(1);
        if ((++sp & 255u) == 0u) { if (xb_ld(&bar[XB_TMO])) break; if (sp > XB_SPIN_CAP) { atomicAdd(&bar[XB_TMO], 1u); break; } }
    }
    nloc = mine > 0u ? mine : 1u; nx = cnt > 0u ? cnt : 1u;
}

__device__ __forceinline__ void xcd_barrier(const XcdBarrier& b) {
    asm volatile("s_waitcnt vmcnt(0)" ::: "memory");
    __syncthreads();
    if (threadIdx.x == 0) {
        unsigned* bar = b.bar;
        __builtin_amdgcn_s_waitcnt(0);
        unsigned nloc = b.st[0], nx = b.st[1];
        if (nloc == 0u) { xcd_barrier_complete(bar, b.x, nloc, nx); b.st[0] = nloc; b.st[1] = nx; }
        const unsigned old = xb_add(&bar[XB_XSUB(b.x)], 1u);
        const unsigned gen = old / nloc;
        if (old + 1u == (gen + 1u) * nloc) {
            __builtin_amdgcn_fence(__ATOMIC_RELEASE, "agent");
            asm volatile("s_waitcnt vmcnt(0)" ::: "memory");
            const unsigned og = xb_add(&bar[XB_TOP], 1u);
            const unsigned tg = og / nx;
            if (og + 1u == (tg + 1u) * nx) xb_add(&bar[XB_TOPGEN], 1u);
            else XB_SPIN(xb_ld(&bar[XB_TOPGEN]) == tg, bar);
            __builtin_amdgcn_fence(__ATOMIC_ACQUIRE, "agent");
            xb_add(&bar[XB_XGEN(b.x)], 1u);
            asm volatile("s_waitcnt vmcnt(0)" ::: "memory");
        } else {
            XB_SPIN(xb_ld(&bar[XB_XGEN(b.x)]) == gen, bar);
            __builtin_amdgcn_fence(__ATOMIC_ACQUIRE, "agent");
            asm volatile("s_waitcnt vmcnt(0)" ::: "memory");
        }
    }
    __syncthreads();
}
__global__ void __launch_bounds__(512, 2) fwd_kernel(Params p_unused) {
    extern __shared__ __attribute__((aligned(16))) unsigned char lds_raw[];
    cg::grid_group grid = cg::this_grid();
    KPtr kp = (KPtr)__builtin_amdgcn_kernarg_segment_ptr();
    LAS unsigned char* lds = (LAS unsigned char*)lds_raw;
    const int wave = __builtin_amdgcn_readfirstlane((int)threadIdx.x >> 6);
#define lane (lane_id_asm())
#define tid (wave * 64 + lane)
#define PH_IDS const int wv = sopaque(wave), bid = sopaque((int)blockIdx.x), G = sopaque((int)gridDim.x), gw = bid * 8 + wv, NGW = G * 8, vcu = (G % 8 == 0) ? (bid % 8) * (G / 8) + bid / 8 : bid, gwx = vcu * 8 + wv; (void)gw; (void)NGW; (void)wv; (void)gwx

    volatile LAS unsigned* bst = (volatile LAS unsigned*)(lds + LDS_BAR_OFF);
    if (tid < 64) bst[tid] = 0u;
    {
        KPtr q = kopaque(kp); unsigned* bw = (unsigned*)(q->ws + WS_BAR);
        if (blockIdx.x == 0) for (int i = tid; i < XCD_BAR_WORDS; i += 512) bw[i] = 0u;
    }
    __syncthreads();
    phase0a(kp, lds, tid, wave, lane);
    grid.sync();
    { KPtr q = kopaque(kp); (void)xcd_barrier_post((unsigned*)(q->ws + WS_BAR), bst); }
#define GRID_BAR() do { XcdBarrier b_; b_.bar = (unsigned*)(kopaque(kp)->ws + WS_BAR); b_.x = xb_xcc_id(); b_.st = (volatile LAS unsigned*)(lds + LDS_BAR_OFF); xcd_barrier(b_); } while (0)
    { PH_IDS; phase0b(kp, lds, gw, NGW, wv, lane); }
    GRID_BAR();

#pragma unroll 1
    for (int l = 0; l < 2; ++l) {
        if (l == 0) {
            PH_IDS; KPtr q = kopaque(kp); unsigned char* ws = q->ws;
            const float* mod = (const float*)(ws + WS_MOD);
            sw_phase(mod, q->w_in, q->w_ff1, (float*)(ws + WS_SW), lds, gw, NGW, wv, lane);
            xa_phase(q->x_prompt, q->x_sample, MP, q->norm1_g, mod + 1 * D, (bf16*)(ws + WS_H), (float*)(ws + WS_RSS), gw, NGW, lane);
            transposes<2>(kp, lds, gw, NGW, wv, lane);
            GRID_BAR();
        }
        {
            PH_IDS; KPtr q = kopaque(kp); unsigned char* ws = q->ws;
            pg8::Gemm g{(const bf16*)(ws + WS_H), (const bf16*)(ws + WS_WIN) + (size_t)l * DIN * D, MTOT, DIN, D}; pg8::StaticOrder S; S.init(MTOT, DIN, G, bid);
            pg8::EpiBf16N<0> E{(bf16*)(ws + WS_PROJ), DIN, (const float*)(ws + WS_RSS) + (size_t)(2 * l) * MTOT, (const float*)(ws + WS_SW) + (size_t)(2 * l) * 5 * 4096, 4096, 0, 640, 1152};
            pg8::gemm_phase<pg8::EpiBf16N<0>, pg8::StaticOrder, true, true>(lds, g, S, E, wv);
        }
        GRID_BAR();
        {
            PH_IDS; KPtr q = kopaque(kp); unsigned char* ws = q->ws;
            const float* ropeC = (const float*)(ws + WS_ROPE);
            bf16* PROJ = (bf16*)(ws + WS_PROJ); bf16* KF = (bf16*)(ws + WS_KF); bf16* VF = (bf16*)(ws + WS_VF);
            const float *ka = q->ka_g + l * 64, *bvg = q->bv_g + l * 256, *kc = q->kc_g + l * 64;
            const int lane_o = vopaque(tid) & 63;
#pragma unroll 1
            for (int task = gwx; task < 15360; task += NGW) prep_task(task, PROJ, KF, VF, ka, bvg, kc, ropeC, ropeC + 16384 * 8, lds + wv * 8192, lane_o);
            __syncthreads();
        }
        GRID_BAR();
        {
        {
            PH_IDS; KPtr q = kopaque(kp); unsigned char* ws = q->ws;
            const bf16* PROJ = (const bf16*)(ws + WS_PROJ); const bf16* KF = (const bf16*)(ws + WS_KF); const bf16* VF = (const bf16*)(ws + WS_VF); bf16* MIXB = (bf16*)(ws + WS_MIX);
            const float* sink = q->a_sink + l * 6; const float* wsp = q->w_sp + (size_t)l * 4 * 128 * 128; const float* bsp = q->b_sp + l * 4 * 128; const float* rb = q->rel_bias + l * 6 * 465;
            const int tid_o = vopaque(tid), lane_o = tid_o & 63;
            int btask = gwx;
#pragma unroll 1
            for (int it = vcu; it < 2304; it += G) { mixer_c_item(it, PROJ, KF, VF, MIXB, rb, q->qc_g + l * 64, lds, tid_o, wv, lane_o, btask, wsp, bsp); btask += NGW; }
#pragma unroll 1
            for (int it = vcu; it < 768; it += G) { mixer_a_item(it, PROJ, KF, VF, MIXB, sink, q->qa_g + l * 64, (const float*)(ws + WS_ROPE), lds, wv, lane_o, btask, wsp, bsp); btask += NGW; }
#pragma unroll 1
            for (; btask < 12288; btask += NGW) mixer_b_task(btask, PROJ, VF, MIXB, wsp, bsp, lane_o);
            __syncthreads();
        }
        }
        GRID_BAR();
        {
            PH_IDS; KPtr q = kopaque(kp); unsigned char* ws = q->ws; float* out = q->out;
            const float* mod_l = (const float*)(ws + WS_MOD) + (size_t)l * 5 * MODW;
            const float* xa = (l == 0) ? q->x_prompt : out; const float* xb = (l == 0) ? q->x_sample : out; const int split = (l == 0) ? MP : (1 << 30);
            pg8::Gemm g{(const bf16*)(ws + WS_MIX), (const bf16*)(ws + WS_WOUT) + (size_t)l * D * D, MTOT, D, D}; pg8::StaticOrder S; S.init(MTOT, D, G, bid);
            if (l == 0) {
                pg8::EpiResGateN<false, true> E{xa, xb, split, nullptr, nullptr, (bf16*)(ws + WS_X1B), mod_l + 2 * D, MODW, 0, (bf16*)(ws + WS_H), q->norm2_g + l * D, mod_l + 4 * D, (float*)(ws + WS_RSS) + (size_t)(2 * l + 1) * MTOT, 1};
                pg8::gemm_phase<pg8::EpiResGateN<false, true>, pg8::StaticOrder, true, true>(lds, g, S, E, wv);
            } else {
                pg8::EpiResGateN<true, true> E{nullptr, nullptr, 0, (const bf16*)out, nullptr, (bf16*)(ws + WS_X1B), mod_l + 2 * D, MODW, 0, (bf16*)(ws + WS_H), q->norm2_g + l * D, mod_l + 4 * D, (float*)(ws + WS_RSS) + (size_t)(2 * l + 1) * MTOT, 1};
                pg8::gemm_phase<pg8::EpiResGateN<true, true>, pg8::StaticOrder, true, true>(lds, g, S, E, wv);
            }
        }
        GRID_BAR();
#pragma unroll 1
        for (int ph = 0; ph <= NCHUNK; ++ph) {
#pragma unroll 1
            for (int step = 0; step < 2; ++step) {
            const bool swp = (sopaque((int)blockIdx.x) >> 3) & 1;
            const bool do1 = (step == 0) != swp;
            if (do1 && ph < NCHUNK) {
                const int c = ph;
                PH_IDS; KPtr q = kopaque(kp); unsigned char* ws = q->ws;
                pg8::Gemm g{(const bf16*)(ws + WS_H) + (size_t)c * CHUNK_ROWS * D, (const bf16*)(ws + WS_WFF1) + (size_t)l * DFF * D, CHUNK_ROWS, DFF, D}; pg8::StaticOrder S; S.init(CHUNK_ROWS, DFF, G, bid);
                pg8::EpiBf16N<2> E{(bf16*)(ws + WS_FFH + (size_t)(c & 1) * FFH_BYTES), DFF, (const float*)(ws + WS_RSS) + (size_t)(2 * l + 1) * MTOT, (const float*)(ws + WS_SW) + (size_t)(2 * l + 1) * 5 * 4096, 4096, c * CHUNK_ROWS, 0, 0};
                pg8::gemm_phase<pg8::EpiBf16N<2>, pg8::StaticOrder, true, true>(lds, g, S, E, wv);
            }
            if (!do1 && ph > 0) {
                const int c = ph - 1;
                PH_IDS; KPtr q = kopaque(kp); unsigned char* ws = q->ws; float* out = q->out;
                const float* mod_l = (const float*)(ws + WS_MOD) + (size_t)l * 5 * MODW;
                pg8::Gemm g{(const bf16*)(ws + WS_FFH + (size_t)(c & 1) * FFH_BYTES), (const bf16*)(ws + WS_WFF2) + (size_t)l * D * DFF, CHUNK_ROWS, D, DFF}; pg8::StaticOrder S; S.init(CHUNK_ROWS, D, G, bid);
                const float* mod_n = (const float*)(ws + WS_MOD) + (size_t)1 * 5 * MODW;
                if (l == 0) {
                    pg8::EpiResGateN<true, true> E{nullptr, nullptr, 0, (const bf16*)(ws + WS_X1B), nullptr, (bf16*)out, mod_l + 5 * D, MODW, c * CHUNK_ROWS, (bf16*)(ws + WS_H), q->norm1_g + 1 * D, mod_n + 1 * D, (float*)(ws + WS_RSS) + (size_t)2 * MTOT, 1};
                    pg8::gemm_phase<pg8::EpiResGateN<true, true>, pg8::StaticOrder, true, true>(lds, g, S, E, wv);
                } else {
                    pg8::EpiResGateN<true, false> E{nullptr, nullptr, 0, (const bf16*)(ws + WS_X1B), out, nullptr, mod_l + 5 * D, MODW, c * CHUNK_ROWS, (bf16*)(ws + WS_H), q->norm1_g + 1 * D, mod_n + 1 * D, (float*)(ws + WS_RSS) + (size_t)2 * MTOT, 0};
                    pg8::gemm_phase<pg8::EpiResGateN<true, false>, pg8::StaticOrder, true, true>(lds, g, S, E, wv);
                }
            }
            }
            if (!(l == 1 && ph == NCHUNK)) GRID_BAR();
        }
    }
#undef lane
#undef tid
}

extern "C" void kernel_launch(void* const* d_in, const int* in_sizes, int n_in, void* d_out, int out_size, void* d_ws, size_t ws_size, hipStream_t stream) {
    static int grid_blocks = 0;
    if (grid_blocks == 0) {
        if (n_in != 21 || ws_size < WS_END) { fprintf(stderr, "kernel_launch: unexpected n_in %d / ws_size %zu\n", n_in, ws_size); grid_blocks = -1; return; }
        int dev = 0, cus = 0, per_cu = 0;
        hipGetDevice(&dev);
        hipDeviceGetAttribute(&cus, hipDeviceAttributeMultiprocessorCount, dev);
        hipFuncSetAttribute((const void*)fwd_kernel, hipFuncAttributeMaxDynamicSharedMemorySize, LDS_BYTES);
        hipOccupancyMaxActiveBlocksPerMultiprocessor(&per_cu, (const void*)fwd_kernel, 512, LDS_BYTES);
        if (per_cu < 1) per_cu = 1;
        grid_blocks = cus * per_cu;
        (void)hipGetLastError();
    }
    if (grid_blocks < 0) return;
    Params p{};
    const float** pp = (const float**)&p;
    for (int i = 0; i < 21; ++i) pp[i] = (const float*)d_in[i];
    p.out = (float*)d_out; p.ws = (unsigned char*)d_ws;
    void* args[] = {&p};
    hipError_t e = hipLaunchCooperativeKernel((const void*)fwd_kernel, dim3(grid_blocks), dim3(512), args, LDS_BYTES, stream);
    if (e != hipSuccess) fprintf(stderr, "cooperative launch failed: %s (grid %d)\n", hipGetErrorString(e), grid_blocks);
}
```
